# Optimizing an MI355X kernel written in HIP

```python
import jax, jax.numpy as jnp
from jax import lax
import numpy as np

D_MODEL = 1024
BATCH = 4
SEQ = 8192
DEPTH = 2

GRID_W = 64
CTX_LEN = 256
N_EVEN = (DEPTH + 1) // 2
N_ODD = DEPTH // 2
NORM_EPS = 1e-6

MLA_HEADS = 8
QK_NOPE = 64
QK_ROPE = 32
QK_HEAD = QK_NOPE + QK_ROPE
V_HEAD = 64
Q_LORA = 384
KV_LORA = 256
ROPE_FREQS = QK_ROPE // 4
ROPE_BASE = 10000.0
Q_BLOCK = 128
MLA_WIDTH = MLA_HEADS * V_HEAD
FNET_GROUPS = 4
FNET_GROUP_DIM = 128
FNET_WIDTH = FNET_GROUPS * FNET_GROUP_DIM
EVEN_WIDTH = MLA_WIDTH + FNET_WIDTH
E_KR0 = KV_LORA
E_Q0 = KV_LORA + QK_ROPE
E_F0 = E_Q0 + Q_LORA
E_G0 = E_F0 + FNET_WIDTH
EVEN_IN = E_G0 + EVEN_WIDTH
RWKV_HEAD = 64
RWKV_WIDTH = D_MODEL
RWKV_HEADS = RWKV_WIDTH // RWKV_HEAD
DECAY_LORA = 64
AAA_LORA = 64
N_DIR = 2
GN_EPS = 64e-5
SHIFT_W = 3
O_V0 = RWKV_WIDTH
O_WD0 = 2 * RWKV_WIDTH
O_AD0 = O_WD0 + N_DIR * DECAY_LORA
O_R0 = O_AD0 + N_DIR * AAA_LORA
STATE_CH = O_R0
CONV_CH = O_R0 + RWKV_WIDTH
ODD_IN = CONV_CH + RWKV_WIDTH

kernel_name = 'hybrid_mla_fnet_rwkv7_dit'


def rms_norm(x, g):
    x32 = x.astype(jnp.float32)
    y = x32 * lax.rsqrt(jnp.mean(x32 * x32, axis=-1, keepdims=True) + NORM_EPS)
    return (y * g.astype(jnp.float32)).astype(x.dtype)


def ada_chunks(cond, w, b, n):
    m = jax.nn.silu(cond) @ w[:, :n * D_MODEL] + b[:n * D_MODEL]
    return [m[..., i * D_MODEL:(i + 1) * D_MODEL] for i in range(n)]


def axial_rope(rows):
    row = jnp.repeat(jnp.arange(rows, dtype=jnp.float32), GRID_W)
    col = jnp.tile(jnp.arange(GRID_W, dtype=jnp.float32), rows)
    inv = 1.0 / (ROPE_BASE ** (jnp.arange(ROPE_FREQS, dtype=jnp.float32) / ROPE_FREQS))
    ang = jnp.stack([row[:, None] * inv, col[:, None] * inv], axis=1)
    return jnp.cos(ang), jnp.sin(ang)


def apply_rope_tail(x, cos, sin):
    b, t, h, _ = x.shape
    xp = x[..., QK_NOPE:].reshape(b, t, h, 2, 2, ROPE_FREQS)
    x1, x2 = xp[..., 0, :], xp[..., 1, :]
    cs = cos[None, :, None].astype(x.dtype)
    sn = sin[None, :, None].astype(x.dtype)
    rot = jnp.stack([x1 * cs - x2 * sn, x2 * cs + x1 * sn], axis=-2).reshape(b, t, h, QK_ROPE)
    return jnp.concatenate([x[..., :QK_NOPE], rot], axis=-1)


def mla_kv(u, kv_norm, w_ukv, k_head_norm, rope):
    b, t, _ = u.shape
    ckv = rms_norm(u[..., :KV_LORA], kv_norm)
    kv = (ckv @ w_ukv).reshape(b, t, MLA_HEADS, QK_NOPE + V_HEAD)
    k_pe = jnp.broadcast_to(u[..., E_KR0:E_Q0][:, :, None, :], (b, t, MLA_HEADS, QK_ROPE))
    k = rms_norm(jnp.concatenate([kv[..., :QK_NOPE], k_pe], axis=-1), k_head_norm)
    if rope is not None:
        k = apply_rope_tail(k, *rope)
    return k, kv[..., QK_NOPE:]


def mla_q(u, q_norm, w_uq, q_head_norm, rope):
    b, t, _ = u.shape
    cq = rms_norm(u[..., E_Q0:E_F0], q_norm)
    q = rms_norm((cq @ w_uq).reshape(b, t, MLA_HEADS, QK_HEAD), q_head_norm)
    if rope is not None:
        q = apply_rope_tail(q, *rope)
    return q


def attend_context(q, k, v):
    b, t, h, _ = q.shape
    s = jnp.einsum('bqhe,bkhe->bhqk', q, k).astype(jnp.float32) * (QK_HEAD ** -0.5)
    p = jax.nn.softmax(s, axis=-1).astype(v.dtype)
    return jnp.einsum('bhqk,bkhd->bqhd', p, v).reshape(b, t, h * V_HEAD)


def attend_latent(q, k_lat, v_lat, k_ctx, v_ctx):
    b, n, h, _ = q.shape
    nb = n // Q_BLOCK
    qb = q.reshape(b, nb, Q_BLOCK, h, QK_HEAD).transpose(1, 0, 3, 2, 4)
    kl = k_lat.transpose(0, 2, 1, 3)
    vl = v_lat.transpose(0, 2, 1, 3)
    kc = k_ctx.transpose(0, 2, 1, 3)
    vc = v_ctx.transpose(0, 2, 1, 3)

    def one_block(qi):
        s = jnp.concatenate([jnp.einsum('bhqe,bhke->bhqk', qi, kl),
                             jnp.einsum('bhqe,bhke->bhqk', qi, kc)], axis=-1)
        p = jax.nn.softmax(s.astype(jnp.float32) * (QK_HEAD ** -0.5), axis=-1).astype(vl.dtype)
        return (jnp.einsum('bhqk,bhkd->bhqd', p[..., :n], vl)
                + jnp.einsum('bhqk,bhkd->bhqd', p[..., n:], vc))

    o = lax.map(one_block, qb)
    return o.transpose(1, 0, 3, 2, 4).reshape(b, n, h * V_HEAD)


def fourier_mix(u, w_fnet):
    b, t, _ = u.shape
    ug = u.reshape(b, t, FNET_GROUPS, FNET_GROUP_DIM).astype(jnp.float32)
    f = jnp.fft.fft2(ug, axes=(1, 3), norm='ortho').real.astype(u.dtype)
    return jnp.einsum('btgc,gcd->btgd', f, w_fnet).reshape(b, t, FNET_WIDTH)


def even_mixer(h_lat, h_ctx, rope, need_ctx, w_in, kv_norm, q_norm, w_uq, w_ukv,
               q_head_norm, k_head_norm, w_fnet, w_out):
    u_lat = h_lat @ w_in
    u_ctx = h_ctx @ (w_in if need_ctx else w_in[:, :E_Q0])
    k_c, v_c = mla_kv(u_ctx, kv_norm, w_ukv, k_head_norm, None)
    k_l, v_l = mla_kv(u_lat, kv_norm, w_ukv, k_head_norm, rope)
    q_l = mla_q(u_lat, q_norm, w_uq, q_head_norm, rope)

    def merge(o, u):
        mix = jnp.concatenate([o, fourier_mix(u[..., E_F0:E_G0], w_fnet)], axis=-1)
        return (mix * jax.nn.silu(u[..., E_G0:])) @ w_out

    y_lat = merge(attend_latent(q_l, k_l, v_l, k_c, v_c), u_lat)
    y_ctx = None
    if need_ctx:
        q_c = mla_q(u_ctx, q_norm, w_uq, q_head_norm, None)
        y_ctx = merge(attend_context(q_c, k_c, v_c), u_ctx)
    return y_lat, y_ctx


def token_shift(z, w):
    zp = jnp.pad(z, ((0, 0), (1, 1), (0, 0)))
    return w[0] * zp[:, :-2] + w[1] * z + w[2] * zp[:, 2:]


def rwkv_scan(w, k, v, kk, a, r, s0, reverse):
    seqs = [jnp.moveaxis(t_, 1, 0) for t_ in (w, k, v, kk, a)]
    if r is not None:
        seqs.append(jnp.moveaxis(r, 1, 0))

    def step(s, inp):
        w_t, k_t, v_t, kk_t, a_t = inp[:5]
        sa = jnp.einsum('bhvk,bhk->bhv', s, kk_t)
        s = (s * w_t[:, :, None, :]
             - sa[..., None] * (kk_t * a_t)[:, :, None, :]
             + v_t[..., None] * k_t[:, :, None, :])
        y = jnp.einsum('bhvk,bhk->bhv', s, inp[5]) if len(inp) > 5 else None
        return s, y

    s_fin, ys = lax.scan(step, s0, tuple(seqs), reverse=reverse)
    return s_fin, (None if r is None else jnp.moveaxis(ys, 0, 1))


def head_group_norm(y, w, b):
    bsz, t, _, _ = y.shape
    mu = jnp.mean(y, axis=-1, keepdims=True)
    var = jnp.mean(jnp.square(y - mu), axis=-1, keepdims=True)
    yn = ((y - mu) * lax.rsqrt(var + GN_EPS)).reshape(bsz, t, RWKV_WIDTH)
    return yn * w + b


def rwkv_time_mix(z, gate, s0, w0, w2, a0, a2, k_k, k_a, r_k, gn_w, gn_b, w_out, with_out):
    b, t, _ = z.shape
    heads = lambda a_: a_.reshape(b, t, RWKV_HEADS, RWKV_HEAD)
    z32 = z.astype(jnp.float32)
    k = z32[..., :O_V0]
    v = heads(z32[..., O_V0:O_WD0])
    wd = z32[..., O_WD0:O_AD0].reshape(b, t, N_DIR, DECAY_LORA)
    ad = z32[..., O_AD0:STATE_CH].reshape(b, t, N_DIR, AAA_LORA)
    w_raw = w0 + jnp.einsum('btzr,zrc->btzc', jnp.tanh(wd), w2)
    decay = jnp.exp(-jnp.exp(-jax.nn.softplus(-w_raw) - 0.5))
    a = jax.nn.sigmoid(a0 + jnp.einsum('btzr,zrc->btzc', ad, a2))
    kk = heads(k * k_k)
    kk = kk / jnp.maximum(jnp.sqrt(jnp.sum(kk * kk, axis=-1, keepdims=True)), 1e-12)
    k_dir = k[:, :, None, :] * (1.0 + (a - 1.0) * k_a)
    r = heads(z32[..., O_R0:CONV_CH]) if with_out else None
    finals, outs, bonuses = [], [], []
    for d in range(N_DIR):
        kd = heads(k_dir[:, :, d])
        s_fin, ys = rwkv_scan(heads(decay[:, :, d]), kd, v, kk, heads(a[:, :, d]), r, s0[d], d == 1)
        finals.append(s_fin)
        if with_out:
            outs.append(ys)
            bonuses.append(jnp.sum(r * kd * r_k, axis=-1, keepdims=True) * v)
    if not with_out:
        return None, finals
    o = head_group_norm(outs[0] + outs[1], gn_w, gn_b) + (bonuses[0] + bonuses[1]).reshape(b, t, RWKV_WIDTH)
    return (o.astype(gate.dtype) * jax.nn.silu(gate)) @ w_out, finals


def odd_mixer(h_lat, h_ctx, need_ctx, w_in, shift_w, w0, w2, a0, a2, k_k, k_a, r_k, gn_w, gn_b, w_out):
    bsz = h_ctx.shape[0]
    s_zero = jnp.zeros((bsz, RWKV_HEADS, RWKV_HEAD, RWKV_HEAD), jnp.float32)
    if need_ctx:
        u_ctx = h_ctx @ w_in
        y_ctx, s_ctx = rwkv_time_mix(token_shift(u_ctx[..., :CONV_CH], shift_w), u_ctx[..., CONV_CH:],
                                     (s_zero, s_zero), w0, w2, a0, a2, k_k, k_a, r_k, gn_w, gn_b, w_out, True)
    else:
        u_ctx = h_ctx @ w_in[:, :STATE_CH]
        y_ctx, s_ctx = rwkv_time_mix(token_shift(u_ctx, shift_w[:, :STATE_CH]), None,
                                     (s_zero, s_zero), w0, w2, a0, a2, k_k, k_a, r_k, gn_w, gn_b, w_out, False)
    u_lat = h_lat @ w_in
    y_lat, _ = rwkv_time_mix(token_shift(u_lat[..., :CONV_CH], shift_w), u_lat[..., CONV_CH:],
                             s_ctx, w0, w2, a0, a2, k_k, k_a, r_k, gn_w, gn_b, w_out, True)
    return y_lat, y_ctx


def setup_inputs(seed: int = 0) -> dict:
    key = jax.random.key(seed)
    ks = iter(list(jax.random.split(key, 40)))
    nrm = lambda shape, scale: jax.random.normal(next(ks), shape, jnp.float32) * scale
    D = D_MODEL
    W = RWKV_WIDTH
    return {
        'x': nrm((BATCH, SEQ, D), 1.0),
        'c': nrm((BATCH, D), 1.0),
        'ctx': nrm((BATCH, CTX_LEN, D), 1.0),
        'c_ctx': nrm((D,), 1.0),
        'ada_w': nrm((DEPTH, D, 3 * D), 0.5 * D ** -0.5),
        'ada_b': nrm((DEPTH, 3 * D), 0.02),
        'norm_g': 1.0 + nrm((DEPTH, D), 0.02),
        'e_w_in': nrm((N_EVEN, D, EVEN_IN), D ** -0.5),
        'e_kv_norm': 1.0 + nrm((N_EVEN, KV_LORA), 0.02),
        'e_q_norm': 1.0 + nrm((N_EVEN, Q_LORA), 0.02),
        'e_w_uq': nrm((N_EVEN, Q_LORA, MLA_HEADS * QK_HEAD), Q_LORA ** -0.5),
        'e_w_ukv': nrm((N_EVEN, KV_LORA, MLA_HEADS * (QK_NOPE + V_HEAD)), KV_LORA ** -0.5),
        'e_q_head_norm': 1.0 + nrm((N_EVEN, QK_HEAD), 0.02),
        'e_k_head_norm': 1.0 + nrm((N_EVEN, QK_HEAD), 0.02),
        'e_w_fnet': nrm((N_EVEN, FNET_GROUPS, FNET_GROUP_DIM, FNET_GROUP_DIM), FNET_GROUP_DIM ** -0.5),
        'e_w_out': nrm((N_EVEN, EVEN_WIDTH, D), EVEN_WIDTH ** -0.5),
        'o_w_in': nrm((N_ODD, D, ODD_IN), D ** -0.5),
        'o_shift_w': jnp.array([0.3, 1.0, 0.3], jnp.float32)[None, :, None] + nrm((N_ODD, SHIFT_W, CONV_CH), 0.05),
        'o_w0': jnp.linspace(-5.0, -1.0, W, dtype=jnp.float32)[None, None, :] + nrm((N_ODD, N_DIR, W), 0.3),
        'o_w2': nrm((N_ODD, N_DIR, DECAY_LORA, W), 0.1 * DECAY_LORA ** -0.5),
        'o_a0': nrm((N_ODD, N_DIR, W), 0.1),
        'o_a2': nrm((N_ODD, N_DIR, AAA_LORA, W), AAA_LORA ** -0.5),
        'o_k_k': 0.85 + nrm((N_ODD, W), 0.02),
        'o_k_a': 1.0 + nrm((N_ODD, W), 0.02),
        'o_r_k': nrm((N_ODD, RWKV_HEADS, RWKV_HEAD), 0.1),
        'o_gn_w': 1.0 + nrm((N_ODD, W), 0.02),
        'o_gn_b': nrm((N_ODD, W), 0.02),
        'o_w_out': nrm((N_ODD, W, D), W ** -0.5),
    }


def reference(x, c, ctx, c_ctx, ada_w, ada_b, norm_g, e_w_in, e_kv_norm, e_q_norm, e_w_uq, e_w_ukv,
              e_q_head_norm, e_k_head_norm, e_w_fnet, e_w_out, o_w_in, o_shift_w, o_w0, o_w2, o_a0,
              o_a2, o_k_k, o_k_a, o_r_k, o_gn_w, o_gn_b, o_w_out):
    rows = x.shape[1] // GRID_W
    rope = axial_rope(rows)
    cond_lat = c[:, None, :]
    cond_ctx = c_ctx[None, None, :]
    for layer in range(DEPTH):
        need_ctx = layer < DEPTH - 1
        shift_l, scale_l, gate_l = ada_chunks(cond_lat, ada_w[layer], ada_b[layer], 3)
        mod_c = ada_chunks(cond_ctx, ada_w[layer], ada_b[layer], 3 if need_ctx else 2)
        h_lat = rms_norm(x, norm_g[layer]) * (1.0 + scale_l) + shift_l
        h_ctx = rms_norm(ctx, norm_g[layer]) * (1.0 + mod_c[1]) + mod_c[0]
        j = layer // 2
        if layer % 2 == 0:
            y_lat, y_ctx = even_mixer(h_lat, h_ctx, rope, need_ctx, e_w_in[j], e_kv_norm[j], e_q_norm[j],
                                      e_w_uq[j], e_w_ukv[j], e_q_head_norm[j], e_k_head_norm[j],
                                      e_w_fnet[j], e_w_out[j])
        else:
            y_lat, y_ctx = odd_mixer(h_lat, h_ctx, need_ctx, o_w_in[j], o_shift_w[j], o_w0[j], o_w2[j],
                                     o_a0[j], o_a2[j], o_k_k[j], o_k_a[j], o_r_k[j], o_gn_w[j],
                                     o_gn_b[j], o_w_out[j])
        x = x + gate_l * y_lat
        if need_ctx:
            ctx = ctx + mod_c[2] * y_ctx
    return x
```

```cpp
#include <hip/hip_runtime.h>
#include <hip/hip_cooperative_groups.h>
#include <stdint.h>
#include <type_traits>
#include <stdio.h>
namespace cg = cooperative_groups;

#define DI __device__ __forceinline__
typedef unsigned short bf16_t;
typedef __attribute__((ext_vector_type(8))) short bf16x8;
typedef __attribute__((ext_vector_type(16))) float f32x16;
typedef __attribute__((ext_vector_type(4))) unsigned int u32x4;
typedef __attribute__((ext_vector_type(2))) unsigned int u32x2;

#ifndef N_LAUNCH_MODE
#define N_LAUNCH_MODE 1
#endif

DI int get_tid() { int t = threadIdx.x; asm volatile("" : "+v"(t)); return t; }
DI bf16_t f2bf(float x) { unsigned u = __float_as_uint(x); u += 0x7fffu + ((u >> 16) & 1u); return (bf16_t)(u >> 16); }
DI float bf2f(bf16_t b) { return __uint_as_float(((unsigned)b) << 16); }
typedef __bf16 bf2_t __attribute__((ext_vector_type(2)));
typedef float f2_t __attribute__((ext_vector_type(2)));
DI unsigned pack2(float a, float b) { f2_t v = {a, b}; return __builtin_bit_cast(unsigned, __builtin_convertvector(v, bf2_t)); }
DI float lo2f(unsigned u) { return __uint_as_float(u << 16); }
DI float hi2f(unsigned u) { return __uint_as_float(u & 0xffff0000u); }
DI float siluf(float x) { return x / (1.f + __expf(-x)); }
DI float sigm(float x) { return __builtin_amdgcn_rcpf(1.f + __expf(-x)); }

constexpr int D = 1024, NB = 4, SEQ = 8192, CTX = 256;
constexpr int NL = NB * SEQ, NC = NB * CTX, NR = NL + NC;
constexpr int KEYS = SEQ + CTX;
constexpr float EPS = 1e-6f;
constexpr float QSCALE = 0.10206207261596577f * 1.4426950408889634f;

constexpr size_t OFF_WINE = 0;
constexpr size_t OFF_WUKV = OFF_WINE + 2816ull * 1024 * 2;
constexpr size_t OFF_WUQ = OFF_WUKV + 1024ull * 256 * 2;
constexpr size_t OFF_WOUTE = OFF_WUQ + 1024ull * 384 * 2;
constexpr size_t OFF_WINO = OFF_WOUTE + 1024ull * 1024 * 2;
constexpr size_t OFF_WOUTO = OFF_WINO + 4352ull * 1024 * 2;
constexpr size_t OFF_DFT128 = OFF_WOUTO + 1024ull * 1024 * 2;
constexpr size_t OFF_DFT64 = OFF_DFT128 + 256 * 256 * 2;
constexpr size_t OFF_DFTC = OFF_DFT64 + 128 * 128 * 2;
constexpr size_t OFF_MAB = OFF_DFTC + 256 * 512 * 2;
constexpr size_t OFF_MOD = OFF_MAB + 8 * 128 * 128 * 4;
constexpr size_t OFF_CTX1 = OFF_MOD + 2 * 5 * 3072 * 4;
constexpr size_t OFF_TW = OFF_CTX1 + 1024ull * 1024 * 4;
constexpr size_t OFF_BIG = 32ull << 20;
constexpr size_t OFF_FLG = OFF_BIG - 65536;
constexpr size_t OFF_SSQ = OFF_TW + 65536;
constexpr size_t OFF_BIAS1 = OFF_SSQ + (size_t)NR * 8 * 4;
static_assert(OFF_BIAS1 + 5 * 4352 * 4 <= OFF_FLG, "small region overflow");
constexpr size_t OFF_H = OFF_BIG;
constexpr size_t OFF_UKVQ = OFF_H + (size_t)NR * 1024 * 2;
constexpr size_t OFF_ZT = OFF_UKVQ + (size_t)NR * 768 * 2;
constexpr size_t OFF_ZC = OFF_ZT + 4ull * 512 * 64 * 256 * 2;
constexpr size_t OFF_YT = OFF_ZC + 4ull * 512 * 512 * 2;
constexpr size_t OFF_G0 = OFF_YT + 4ull * 128 * 512 * 128 * 2;
constexpr size_t OFF_Q = OFF_G0 + (size_t)NR * 1024 * 2;
constexpr size_t OFF_K = OFF_Q + 4ull * 8 * KEYS * 96 * 2;
constexpr size_t OFF_VT = OFF_K + 4ull * 8 * KEYS * 96 * 2;
constexpr size_t END0 = OFF_VT + 4ull * 8 * 64 * KEYS * 2;
constexpr size_t OFF_U1 = OFF_UKVQ;
constexpr size_t OFF_Y1 = OFF_U1 + (size_t)NR * 4352 * 2;
constexpr size_t OFF_BS = OFF_Y1 + (size_t)NL * 1024 * 2;
constexpr size_t OFF_RING = OFF_BS + 2ull * NL * 16 * 4;
constexpr size_t OFF_A1 = OFF_Y1;
static_assert(OFF_A1 + (size_t)NR * 1024 * 2 <= OFF_RING, "A1 overlaps the ring");
constexpr size_t END1 = OFF_RING + 128ull * 16 * 28672;
static_assert(END0 <= (512ull << 20) && END1 <= (512ull << 20), "workspace overflow");

struct Params {
  const float *x, *c, *ctx, *c_ctx, *ada_w, *ada_b, *norm_g, *e_w_in, *e_kv_norm, *e_q_norm, *e_w_uq, *e_w_ukv,
      *e_q_head_norm, *e_k_head_norm, *e_w_fnet, *e_w_out, *o_w_in, *o_shift_w, *o_w0, *o_w2, *o_a0, *o_a2, *o_k_k,
      *o_k_a, *o_r_k, *o_gn_w, *o_gn_b, *o_w_out;
  float* out;
  char* ws;
};

constexpr int BK = 64, LDS_LD = 72;
constexpr int OPER_ELEMS = 128 * LDS_LD;
constexpr int CLD = 129;
constexpr int SMEM_MAIN = 4 * OPER_ELEMS * 2;
constexpr int SMEM_BYTES = SMEM_MAIN + 1024;

template <class ARowF, class BRowF>
DI void gemm_mainloop(ARowF arow, BRowF brow, int K, char* smem, f32x16 (&acc)[2][2]) {
  const int tid = get_tid(), lane = tid & 63, wave = tid >> 6;
  const int wm = wave >> 1, wn = wave & 1;
  const int lr = tid >> 3, lc = (tid & 7) * 8;
  const bf16_t* ap[4];
  const bf16_t* bp[4];
#pragma unroll
  for (int i = 0; i < 4; ++i) { ap[i] = arow(lr + 32 * i) + lc; bp[i] = brow(lr + 32 * i) + lc; }
  const int KT = K / BK;
  u32x4 ra[2][4], rb[2][4];
#pragma unroll
  for (int i = 0; i < 4; ++i) { ra[0][i] = *(const u32x4*)(ap[i]); rb[0][i] = *(const u32x4*)(bp[i]); }
  if (KT > 1) {
#pragma unroll
    for (int i = 0; i < 4; ++i) { ra[1][i] = *(const u32x4*)(ap[i] + BK); rb[1][i] = *(const u32x4*)(bp[i] + BK); }
  }
  bf16_t* S = (bf16_t*)smem;
#pragma unroll
  for (int i = 0; i < 4; ++i) {
    *(u32x4*)(S + (lr + 32 * i) * LDS_LD + lc) = ra[0][i];
    *(u32x4*)(S + OPER_ELEMS + (lr + 32 * i) * LDS_LD + lc) = rb[0][i];
  }
  __syncthreads();
  const int arow_off = (wm * 64 + (lane & 31)) * LDS_LD + (lane >> 5) * 8;
  const int brow_off = (wn * 64 + (lane & 31)) * LDS_LD + (lane >> 5) * 8;
  auto step = [&](int kt, u32x4 (&rna)[4], u32x4 (&rnb)[4], u32x4 (&rfa)[4], u32x4 (&rfb)[4]) {
    const bf16_t* Ac = S + (kt & 1) * 2 * OPER_ELEMS;
    const bf16_t* Bc = Ac + OPER_ELEMS;
    if (kt + 2 < KT) {
#pragma unroll
      for (int i = 0; i < 4; ++i) {
        rfa[i] = *(const u32x4*)(ap[i] + (kt + 2) * BK);
        rfb[i] = *(const u32x4*)(bp[i] + (kt + 2) * BK);
      }
    }
    __builtin_amdgcn_sched_barrier(0);
#pragma unroll
    for (int ks = 0; ks < 4; ++ks) {
      bf16x8 a0 = *(const bf16x8*)(Ac + arow_off + ks * 16);
      bf16x8 a1 = *(const bf16x8*)(Ac + arow_off + 32 * LDS_LD + ks * 16);
      bf16x8 b0 = *(const bf16x8*)(Bc + brow_off + ks * 16);
      bf16x8 b1 = *(const bf16x8*)(Bc + brow_off + 32 * LDS_LD + ks * 16);
      acc[0][0] = __builtin_amdgcn_mfma_f32_32x32x16_bf16(a0, b0, acc[0][0], 0, 0, 0);
      acc[0][1] = __builtin_amdgcn_mfma_f32_32x32x16_bf16(a0, b1, acc[0][1], 0, 0, 0);
      acc[1][0] = __builtin_amdgcn_mfma_f32_32x32x16_bf16(a1, b0, acc[1][0], 0, 0, 0);
      acc[1][1] = __builtin_amdgcn_mfma_f32_32x32x16_bf16(a1, b1, acc[1][1], 0, 0, 0);
    }
    if (kt + 1 < KT) {
      bf16_t* An = S + ((kt + 1) & 1) * 2 * OPER_ELEMS;
#pragma unroll
      for (int i = 0; i < 4; ++i) {
        *(u32x4*)(An + (lr + 32 * i) * LDS_LD + lc) = rna[i];
        *(u32x4*)(An + OPER_ELEMS + (lr + 32 * i) * LDS_LD + lc) = rnb[i];
      }
    }
    __syncthreads();
  };
  for (int kt = 0; kt < KT; kt += 2) {
    step(kt, ra[1], rb[1], ra[0], rb[0]);
    if (kt + 1 < KT) step(kt + 1, ra[0], rb[0], ra[1], rb[1]);
  }
}

template <class ARowF, class BRowF, class EpiF>
DI void gemm_tile(ARowF arow, BRowF brow, int K, char* smem, EpiF epi) {
  f32x16 acc[2][2];
#pragma unroll
  for (int i = 0; i < 2; ++i)
#pragma unroll
    for (int j = 0; j < 2; ++j)
#pragma unroll
      for (int r = 0; r < 16; ++r) acc[i][j][r] = 0.f;
  gemm_mainloop(arow, brow, K, smem, acc);
  float* Cs = (float*)smem;
  const int lane = get_tid() & 63, wave = get_tid() >> 6;
  const int wm = wave >> 1, wn = wave & 1;
#pragma unroll
  for (int i = 0; i < 2; ++i)
#pragma unroll
    for (int j = 0; j < 2; ++j)
#pragma unroll
      for (int r = 0; r < 16; ++r) {
        int row = wm * 64 + i * 32 + (r & 3) + 8 * (r >> 2) + 4 * (lane >> 5);
        int col = wn * 64 + j * 32 + (lane & 31);
        Cs[row * CLD + col] = acc[i][j][r];
      }
  __syncthreads();
  epi(Cs);
  __syncthreads();
}

template <class RowPtrF>
DI void store_tile_bf16(const float* Cs, RowPtrF rowptr, bool do_silu) {
  const int tid = get_tid();
#pragma unroll
  for (int q = 0; q < 8; ++q) {
    const int c = tid + 256 * q;
    const int i = c >> 4, ch = c & 15;
    float v[8];
#pragma unroll
    for (int e = 0; e < 8; ++e) { v[e] = Cs[i * CLD + ch * 8 + e]; if (do_silu) v[e] = siluf(v[e]); }
    u32x4 pk;
    pk[0] = pack2(v[0], v[1]); pk[1] = pack2(v[2], v[3]); pk[2] = pack2(v[4], v[5]); pk[3] = pack2(v[6], v[7]);
    *(u32x4*)(rowptr(i) + ch * 8) = pk;
  }
}

DI void store_row64(const float* crow, bf16_t* dst, bool do_silu) {
#pragma unroll
  for (int q = 0; q < 8; ++q) {
    float v[8];
#pragma unroll
    for (int e = 0; e < 8; ++e) { v[e] = crow[q * 8 + e]; if (do_silu) v[e] = siluf(v[e]); }
    u32x4 pk;
    pk[0] = pack2(v[0], v[1]); pk[1] = pack2(v[2], v[3]); pk[2] = pack2(v[4], v[5]); pk[3] = pack2(v[6], v[7]);
    *(u32x4*)(dst + q * 8) = pk;
  }
}

template <class F>
DI void tile_walk(int NG, int NNT, F f) {
  if ((gridDim.x & 7) == 0) {
    const int xcd = blockIdx.x & 7, j = blockIdx.x >> 3, nper = gridDim.x >> 3;
    const int len = (NG >> 3) * NNT * 8;
    for (int t = j; t < len; t += nper) {
      const int gl = t / (NNT * 8), rem = t - gl * (NNT * 8);
      f((gl * 8 + xcd) * 8 + (rem & 7), rem >> 3);
    }
  } else {
    for (int t = blockIdx.x; t < NG * 8 * NNT; t += gridDim.x) f(t / NNT, t % NNT);
  }
}

DI int srccol(int mapid, int n) {
  if (mapid == 0) return n;
  if (mapid == 1) return n < 256 ? n : (n < 640 ? n + 32 : (n < 672 ? n - 640 + 256 : -1));
  if (mapid == 2) return 1184 + n;
  return (n & 127) < 96 ? (n >> 7) * 96 + (n & 127) : -1;
}

DI void transpose_item(const float* src, int lds, bf16_t* dst, int ldd, int mapid, const float* scale, int kt, int ntile,
                       char* smem) {
  float* t = (float*)smem;
  const int tid = get_tid();
  const int k0 = kt * 64, n0 = ntile * 64;
  {
    const int n = tid & 63;
    const int sc = srccol(mapid, n0 + n);
#pragma unroll 4
    for (int p = 0; p < 16; ++p) {
      int k = p * 4 + (tid >> 6);
      float v = 0.f;
      if (sc >= 0) { v = src[(size_t)(k0 + k) * lds + sc]; if (scale) v *= scale[k0 + k]; }
      t[k * 65 + n] = v;
    }
  }
  __syncthreads();
  {
    const int n = tid >> 2, kq = (tid & 3) * 16;
    u32x4 p0, p1;
    float v[16];
#pragma unroll
    for (int i = 0; i < 16; ++i) v[i] = t[(kq + i) * 65 + n];
    p0[0] = pack2(v[0], v[1]); p0[1] = pack2(v[2], v[3]); p0[2] = pack2(v[4], v[5]); p0[3] = pack2(v[6], v[7]);
    p1[0] = pack2(v[8], v[9]); p1[1] = pack2(v[10], v[11]); p1[2] = pack2(v[12], v[13]); p1[3] = pack2(v[14], v[15]);
    bf16_t* d = dst + (size_t)(n0 + n) * ldd + k0 + kq;
    *(u32x4*)d = p0;
    *(u32x4*)(d + 8) = p1;
  }
  __syncthreads();
}

DI void phase_prep1(const Params& p, char* smem) {
  const int tid = get_tid();
  char* ws = p.ws;
  constexpr int N_MOD = 384;
  constexpr int T0 = 16 * 12;
  constexpr int T1 = 16 * 16;
  constexpr int T2 = 6 * 16;
  constexpr int T3 = 4 * 16;
  constexpr int T4 = 16 * 16;
  constexpr int T5 = 16 * 68;
  constexpr int T6 = 16 * 16;
  constexpr int N_TR = T0 + T1 + T2 + T3 + T4 + T5 + T6;
  constexpr int N_TAB = 256 + 64 + 512 + 32;
  constexpr int N_MAB = 512;
  constexpr int TOTAL = N_MOD + N_TR + N_TAB + N_MAB;
  for (int it = blockIdx.x; it < TOTAL; it += gridDim.x) {
    if (it < N_MOD) {
      const int l = it / 192, chunk = it % 192;
      float* scond = (float*)smem;
      float* red = scond + 5120;
      for (int idx = tid; idx < 5120; idx += 256) {
        int j = idx >> 10, k = idx & 1023;
        float cv = j < 4 ? p.c[j * 1024 + k] : p.c_ctx[k];
        scond[idx] = siluf(cv);
      }
      __syncthreads();
      const int kg = tid >> 4, cl = tid & 15;
      const int n = chunk * 16 + cl;
      float a[5] = {0.f, 0.f, 0.f, 0.f, 0.f};
      const float* w = p.ada_w + (size_t)l * 1024 * 3072 + n;
#pragma unroll 16
      for (int k = kg * 64; k < kg * 64 + 64; ++k) {
        float wv = w[(size_t)k * 3072];
#pragma unroll
        for (int j = 0; j < 5; ++j) a[j] += scond[j * 1024 + k] * wv;
      }
#pragma unroll
      for (int j = 0; j < 5; ++j) red[tid * 5 + j] = a[j];
      __syncthreads();
      if (tid < 80) {
        int j = tid >> 4, c2 = tid & 15;
        float s = 0.f;
        for (int g = 0; g < 16; ++g) s += red[(g * 16 + c2) * 5 + j];
        int nn = chunk * 16 + c2;
        ((float*)(ws + OFF_MOD))[(l * 5 + j) * 3072 + nn] = s + p.ada_b[l * 3072 + nn];
      }
      __syncthreads();
      continue;
    }
    int r = it - N_MOD;
    if (r < N_TR) {
      if (r < T0) { transpose_item(p.e_w_in, 2208, (bf16_t*)(ws + OFF_WINE), 1024, 1, nullptr, r % 16, r / 16, smem); continue; }
      r -= T0;
      if (r < T1) { transpose_item(p.e_w_in, 2208, (bf16_t*)(ws + OFF_WINE) + 1792ull * 1024, 1024, 2, nullptr, r % 16, r / 16, smem); continue; }
      r -= T1;
      if (r < T2) { transpose_item(p.e_w_uq, 768, (bf16_t*)(ws + OFF_WUQ), 384, 3, p.e_q_norm, r % 6, r / 6, smem); continue; }
      r -= T2;
      if (r < T3) { transpose_item(p.e_w_ukv, 1024, (bf16_t*)(ws + OFF_WUKV), 256, 0, p.e_kv_norm, r % 4, r / 4, smem); continue; }
      r -= T3;
      if (r < T4) { transpose_item(p.e_w_out, 1024, (bf16_t*)(ws + OFF_WOUTE), 1024, 0, nullptr, r % 16, r / 16, smem); continue; }
      r -= T4;
      if (r < T5) { transpose_item(p.o_w_in, 4352, (bf16_t*)(ws + OFF_WINO), 1024, 0, nullptr, r % 16, r / 16, smem); continue; }
      r -= T5;
      transpose_item(p.o_w_out, 1024, (bf16_t*)(ws + OFF_WOUTO), 1024, 0, nullptr, r % 16, r / 16, smem);
      continue;
    }
    r -= N_TR;
    if (r < N_TAB) {
      if (r < 256) {
        int idx = r * 256 + tid;
        int m = idx >> 8, kk = idx & 255;
        int k2 = m >> 1, ro = m & 1, ri = kk >> 7, n2 = kk & 127;
        float s, c;
        sincospif((float)((n2 * k2) & 127) * (1.f / 64.f), &s, &c);
        float v = (ro == 0) ? (ri == 0 ? c : s) : (ri == 0 ? -s : c);
        ((bf16_t*)(ws + OFF_DFT128))[idx] = f2bf(v);
      } else if (r < 320) {
        int idx = (r - 256) * 256 + tid;
        int k1 = idx >> 7, kk = idx & 127;
        int ro = kk >> 6, n1 = kk & 63;
        float v = 0.f;
        if (k1 < 64) {
          float s, c;
          sincospif((float)((n1 * k1) & 63) * (1.f / 32.f), &s, &c);
          v = (ro == 0 ? c : s) * 0.011048543456039806f;
        }
        ((bf16_t*)(ws + OFF_DFT64))[idx] = f2bf(v);
      } else if (r >= 832) {
        int idx = (r - 832) * 256 + tid;
        int k2 = idx >> 6, n1 = idx & 63;
        float sn, cs;
        sincospif((float)((n1 * k2) & 8191) * (1.f / 4096.f), &sn, &cs);
        ((float2*)(ws + OFF_TW))[idx] = make_float2(cs, sn);
      } else {
        int idx = (r - 320) * 256 + tid;
        int k = idx >> 9, kk = idx & 511;
        int ri = kk >> 8, t = kk & 255;
        float s, c;
        sincospif((float)((k * t) & 255) * (1.f / 128.f), &s, &c);
        ((bf16_t*)(ws + OFF_DFTC))[idx] = f2bf((ri == 0 ? c : s) * 0.0625f);
      }
      continue;
    }
    r -= N_TAB;
    {
      float* tc = (float*)smem;
      if (tid < 128) {
        float s, c;
        sincospif((float)tid * (1.f / 64.f), &s, &c);
        tc[tid] = c; tc[128 + tid] = s;
      }
      __syncthreads();
      const int gt = r >> 6, sub = r & 63;
      const int g = gt >> 1, type = gt & 1;
      const int c = sub * 2 + (tid >> 7), d = tid & 127;
      const float* wf = p.e_w_fnet + (size_t)g * 128 * 128 + d;
      float acc = 0.f;
#pragma unroll 8
      for (int cp = 0; cp < 128; ++cp) acc += tc[type * 128 + ((c * cp) & 127)] * wf[cp * 128];
      const float sc = type ? -0.08838834764831845f : 0.08838834764831845f;
      ((float*)(ws + OFF_MAB))[((size_t)gt * 128 + c) * 128 + d] = acc * sc;
      __syncthreads();
    }
  }
}

DI void norm_rows(const float* xl, const float* xc, const float* g, const float* mod  , bf16_t* hb) {
  const int lane = get_tid() & 63, wave = get_tid() >> 6;
  for (int it = blockIdx.x; it < NR / 4; it += gridDim.x) {
    const int row = it * 4 + wave;
    const float* src;
    int j;
    if (row < NL) { src = xl + (size_t)row * 1024; j = row >> 13; } else { src = xc + (size_t)(row - NL) * 1024; j = 4; }
    float4 v[4];
    float ss = 0.f;
#pragma unroll
    for (int q = 0; q < 4; ++q) {
      v[q] = *(const float4*)(src + q * 256 + lane * 4);
      ss += v[q].x * v[q].x + v[q].y * v[q].y + v[q].z * v[q].z + v[q].w * v[q].w;
    }
#pragma unroll
    for (int o = 32; o >= 1; o >>= 1) ss += __shfl_xor(ss, o);
    const float rs = rsqrtf(ss * (1.f / 1024.f) + EPS);
    const float* sh = mod + j * 3072;
    const float* sc = sh + 1024;
#pragma unroll
    for (int q = 0; q < 4; ++q) {
      const int cidx = q * 256 + lane * 4;
      float4 gg = *(const float4*)(g + cidx);
      float4 s1 = *(const float4*)(sc + cidx);
      float4 s0 = *(const float4*)(sh + cidx);
      float o0 = v[q].x * rs * gg.x * (1.f + s1.x) + s0.x;
      float o1 = v[q].y * rs * gg.y * (1.f + s1.y) + s0.y;
      float o2 = v[q].z * rs * gg.z * (1.f + s1.z) + s0.z;
      float o3 = v[q].w * rs * gg.w * (1.f + s1.w) + s0.w;
      u32x2 pk; pk[0] = pack2(o0, o1); pk[1] = pack2(o2, o3);
      *(u32x2*)(hb + (size_t)row * 1024 + cidx) = pk;
    }
  }
}

DI void phase_prep2(const Params& p, char* smem) {
  const int tid = get_tid();
  char* ws = p.ws;
  for (int it = blockIdx.x; it < 512; it += gridDim.x) {
    const int gt = it >> 6, ch = it & 63;
    const int g = gt >> 1, type = gt & 1;
    float* mab = (float*)smem;
    float* wl = mab + 128 * 128;
    const float* msrc = (const float*)(ws + OFF_MAB) + (size_t)gt * 16384;
    for (int i = tid; i < 16384; i += 256) mab[i] = msrc[i];
    for (int i = tid; i < 2048; i += 256) {
      int kd = i >> 7, c = i & 127;
      wl[i] = p.e_w_in[(size_t)(ch * 16 + kd) * 2208 + 672 + g * 128 + c];
    }
    __syncthreads();
    const int d = tid & 127, half = tid >> 7;
    float acc[8] = {0.f, 0.f, 0.f, 0.f, 0.f, 0.f, 0.f, 0.f};
    for (int c = 0; c < 128; ++c) {
      float m = mab[c * 128 + d];
#pragma unroll
      for (int q = 0; q < 8; ++q) acc[q] += wl[(half * 8 + q) * 128 + c] * m;
    }
    u32x4 pk;
    pk[0] = pack2(acc[0], acc[1]); pk[1] = pack2(acc[2], acc[3]); pk[2] = pack2(acc[4], acc[5]); pk[3] = pack2(acc[6], acc[7]);
    bf16_t* dst = (bf16_t*)(ws + OFF_WINE) + (size_t)(768 + type * 512 + g * 128 + d) * 1024 + ch * 16 + half * 8;
    *(u32x4*)dst = pk;
    __syncthreads();
  }
  {
    const int lane = tid & 63, wave = tid >> 6;
    const float* mod1 = (const float*)(ws + OFF_MOD) + 5 * 3072;
    const bf16_t* Wt = (const bf16_t*)(ws + OFF_WINO);
    for (int it = blockIdx.x; it < 4352 / 4; it += gridDim.x) {
      const int n = it * 4 + wave;
      const u32x4 w0 = *(const u32x4*)(Wt + (size_t)n * 1024 + lane * 16);
      const u32x4 w1 = *(const u32x4*)(Wt + (size_t)n * 1024 + lane * 16 + 8);
      float wv[16];
#pragma unroll
      for (int e = 0; e < 4; ++e) { wv[2 * e] = lo2f(w0[e]); wv[2 * e + 1] = hi2f(w0[e]); wv[8 + 2 * e] = lo2f(w1[e]); wv[8 + 2 * e + 1] = hi2f(w1[e]); }
#pragma unroll
      for (int j = 0; j < 5; ++j) {
        const float* sh = mod1 + j * 3072 + lane * 16;
        float a = 0.f;
#pragma unroll
        for (int q = 0; q < 4; ++q) {
          const float4 s4 = *(const float4*)(sh + q * 4);
          a += s4.x * wv[4 * q] + s4.y * wv[4 * q + 1] + s4.z * wv[4 * q + 2] + s4.w * wv[4 * q + 3];
        }
#pragma unroll
        for (int o = 32; o >= 1; o >>= 1) a += __shfl_xor(a, o);
        if (lane == 0) ((float*)(ws + OFF_BIAS1))[j * 4352 + n] = a;
      }
    }
  }
  norm_rows(p.x, p.ctx, p.norm_g, (const float*)(ws + OFF_MOD), (bf16_t*)(ws + OFF_H));
}

DI int tokrow_e(int mt, int i) { return mt < 256 ? ((mt >> 6) * 8192 + (mt & 63) + 64 * i) : (NL + (mt - 256) * 128 + i); }

DI void phase_inproj_e(const Params& p, char* smem) {
  char* ws = p.ws;
  const int tid = get_tid();
  const bf16_t* hb = (const bf16_t*)(ws + OFF_H);
  const bf16_t* W = (const bf16_t*)(ws + OFF_WINE);
  auto do_tile = [&](int mt, int nt) {
    auto arow = [&](int i) { return hb + (size_t)tokrow_e(mt, i) * 1024; };
    auto brow = [&](int i) { return W + (size_t)(nt * 128 + i) * 1024; };
    gemm_tile(arow, brow, 1024, smem, [&](const float* Cs) {
      if (nt < 6 || nt >= 14) {
        store_tile_bf16(Cs, [&](int i) {
          const int row = tokrow_e(mt, i);
          return (nt < 6) ? (bf16_t*)(ws + OFF_UKVQ) + (size_t)row * 768 + nt * 128
                          : (bf16_t*)(ws + OFF_G0) + (size_t)row * 1024 + (nt - 14) * 128;
        }, nt >= 14);
      } else {
        const int ri = (nt - 6) >> 2, jb = (nt - 6) & 3;
#pragma unroll
        for (int q = 0; q < 8; ++q) {
          const int cc = tid + 256 * q;
          const int c = cc >> 4, ch = cc & 15;
          const int j = jb * 128 + c;
          bf16_t* dst;
          if (mt < 256) {
            const int b = mt >> 6, n1 = mt & 63;
            dst = (bf16_t*)(ws + OFF_ZT) + ((((size_t)b * 512 + j) * 64 + n1) * 2 + ri) * 128 + ch * 8;
          } else {
            const int b = (mt - 256) >> 1, hf = (mt - 256) & 1;
            dst = (bf16_t*)(ws + OFF_ZC) + (((size_t)b * 512 + j) * 2 + ri) * 256 + hf * 128 + ch * 8;
          }
          float v[8];
#pragma unroll
          for (int e = 0; e < 8; ++e) v[e] = Cs[(ch * 8 + e) * CLD + c];
          u32x4 pk;
          pk[0] = pack2(v[0], v[1]); pk[1] = pack2(v[2], v[3]); pk[2] = pack2(v[4], v[5]); pk[3] = pack2(v[6], v[7]);
          *(u32x4*)dst = pk;
        }
      }
    });
  };
  tile_walk(32, 22, do_tile);
  for (int it = blockIdx.x; it < 8 * 22; it += gridDim.x) do_tile(256 + it / 22, it % 22);
}

DI void head_finish(float (&k)[48], int hf, const float* normw, bool lat, int pos, float scale, bf16_t* dst) {
  asm volatile("" : "+s"(normw));
  float ss = 0.f;
#pragma unroll
  for (int e = 0; e < 48; ++e) ss += k[e] * k[e];
  ss += __shfl_xor(ss, 1);
  const float rn = rsqrtf(ss * (1.f / 96.f) + EPS);
#pragma unroll
  for (int e = 0; e < 48; ++e) k[e] = k[e] * rn * normw[hf * 48 + e];
  if (lat && hf == 1) {
    const float inv[8] = {1.f, 0.31622776601683794f, 0.1f, 0.031622776601683794f, 0.01f, 0.0031622776601683794f, 0.001f, 0.00031622776601683794f};
    const float pr = (float)(pos >> 6), pc = (float)(pos & 63);
#pragma unroll
    for (int a = 0; a < 2; ++a)
#pragma unroll
      for (int f = 0; f < 8; ++f) {
        const float ang = (a == 0 ? pr : pc) * inv[f];
        const float sn = __sinf(ang), cs = __cosf(ang);
        const float x1 = k[16 + 16 * a + f], x2 = k[16 + 16 * a + 8 + f];
        k[16 + 16 * a + f] = x1 * cs - x2 * sn;
        k[16 + 16 * a + 8 + f] = x2 * cs + x1 * sn;
      }
  }
#pragma unroll
  for (int q = 0; q < 6; ++q) {
    u32x4 pk;
    pk[0] = pack2(k[q * 8 + 0] * scale, k[q * 8 + 1] * scale); pk[1] = pack2(k[q * 8 + 2] * scale, k[q * 8 + 3] * scale);
    pk[2] = pack2(k[q * 8 + 4] * scale, k[q * 8 + 5] * scale); pk[3] = pack2(k[q * 8 + 6] * scale, k[q * 8 + 7] * scale);
    *(u32x4*)(dst + hf * 48 + q * 8) = pk;
  }
}

DI void row_stats(const bf16_t* base, int ld, int col0, int ncols, float* rstat) {
  const int tid = get_tid(), i = tid >> 1, hf = tid & 1;
  const int half = ncols >> 1;
  const bf16_t* src = base + (size_t)i * ld + col0 + hf * half;
  float ss = 0.f;
  for (int q = 0; q < half / 8; ++q) {
    u32x4 v = *(const u32x4*)(src + q * 8);
#pragma unroll
    for (int e = 0; e < 4; ++e) { float a = lo2f(v[e]), b = hi2f(v[e]); ss += a * a + b * b; }
  }
  ss += __shfl_xor(ss, 1);
  if (hf == 0) rstat[i] = rsqrtf(ss / (float)ncols + EPS);
}

DI void phase_up(const Params& p, char* smem) {
  char* ws = p.ws;
  const int tid = get_tid();
  float* rstat = (float*)(smem + SMEM_MAIN);
  const bf16_t* U = (const bf16_t*)(ws + OFF_UKVQ);
  constexpr int N_KV = 264 * 8, N_Q = 264 * 8, N_F1 = 2048, N_CD = 32;
  auto do_up = [&](int mt, int hq) {
    {
      const bool isq = hq >= 8;
      const int h = hq & 7;
      const int row0 = mt * 128;
      const bool lat = row0 < NL;
      const int b = lat ? (row0 >> 13) : ((row0 - NL) >> 8);
      const int pos0 = lat ? (row0 & 8191) : (8192 + ((row0 - NL) & 255));
      row_stats(U + (size_t)row0 * 768, 768, isq ? 256 : 0, isq ? 384 : 256, rstat);
      if (!isq) {
        const bf16_t* W = (const bf16_t*)(ws + OFF_WUKV);
        auto arow = [&](int i) { return U + (size_t)(row0 + i) * 768; };
        auto brow = [&](int i) { return W + (size_t)(h * 128 + i) * 256; };
        gemm_tile(arow, brow, 256, smem, [&](const float* Cs) {
          {
            const int i = tid >> 1, hf = tid & 1;
            const float rr = rstat[i];
            float k[48];
            if (hf == 0) {
#pragma unroll
              for (int e = 0; e < 48; ++e) k[e] = Cs[i * CLD + e] * rr;
            } else {
#pragma unroll
              for (int e = 0; e < 16; ++e) k[e] = Cs[i * CLD + 48 + e] * rr;
              const bf16_t* pe = U + (size_t)(row0 + i) * 768 + 640;
#pragma unroll
              for (int q = 0; q < 4; ++q) {
                u32x4 v = *(const u32x4*)(pe + q * 8);
#pragma unroll
                for (int e = 0; e < 4; ++e) { k[16 + q * 8 + 2 * e] = lo2f(v[e]); k[16 + q * 8 + 2 * e + 1] = hi2f(v[e]); }
              }
            }
            head_finish(k, hf, p.e_k_head_norm, lat, pos0 + i, 1.f, (bf16_t*)(ws + OFF_K) + ((size_t)(b * 8 + h) * KEYS + pos0 + i) * 96);
          }
#pragma unroll
          for (int q = 0; q < 4; ++q) {
            const int cc = tid + 256 * q;
            const int d = cc >> 4, ch = cc & 15;
            bf16_t* dst = (bf16_t*)(ws + OFF_VT) + ((size_t)(b * 8 + h) * 64 + d) * KEYS + pos0 + ch * 8;
            float v[8];
#pragma unroll
            for (int e = 0; e < 8; ++e) { const int i = ch * 8 + e; v[e] = Cs[i * CLD + 64 + d] * rstat[i]; }
            u32x4 pk;
            pk[0] = pack2(v[0], v[1]); pk[1] = pack2(v[2], v[3]); pk[2] = pack2(v[4], v[5]); pk[3] = pack2(v[6], v[7]);
            *(u32x4*)dst = pk;
          }
        });
      } else {
        const bf16_t* W = (const bf16_t*)(ws + OFF_WUQ);
        auto arow = [&](int i) { return U + (size_t)(row0 + i) * 768 + 256; };
        auto brow = [&](int i) { return W + (size_t)(h * 128 + i) * 384; };
        gemm_tile(arow, brow, 384, smem, [&](const float* Cs) {
          {
            const int i = tid >> 1, hf = tid & 1;
            const float rr = rstat[i];
            float k[48];
#pragma unroll
            for (int e = 0; e < 48; ++e) k[e] = Cs[i * CLD + hf * 48 + e] * rr;
            head_finish(k, hf, p.e_q_head_norm, lat, pos0 + i, QSCALE, (bf16_t*)(ws + OFF_Q) + ((size_t)(b * 8 + h) * KEYS + pos0 + i) * 96);
          }
        });
      }
    }
  };
  tile_walk(32, 16, do_up);
  for (int it = blockIdx.x; it < 128 + N_F1 + N_CD; it += gridDim.x) {
    if (it < 128) { do_up(256 + (it >> 4), it & 15); continue; }
    int r = it - 128;
    if (r < N_F1) {
      const int half = r & 1, jp = (r >> 1) & 255, b = r >> 9;
      const bf16_t* A = (const bf16_t*)(ws + OFF_DFT128) + (size_t)half * 128 * 256;
      const bf16_t* Bt = (const bf16_t*)(ws + OFF_ZT) + ((size_t)b * 512 + jp * 2) * 64 * 256;
      auto arow = [&](int i) { return A + (size_t)i * 256; };
      auto brow = [&](int i) { return Bt + (size_t)i * 256; };
      gemm_tile(arow, brow, 256, smem, [&](const float* Cs) {
        const int n = tid & 127, mh = tid >> 7;
        const int jj = n >> 6, n1 = n & 63;
        const int j = jp * 2 + jj;
        bf16_t* Y = (bf16_t*)(ws + OFF_YT);
#pragma unroll 2
        for (int q = 0; q < 32; ++q) {
          const int k2l = mh * 32 + q;
          const int k2 = half * 64 + k2l;
          const float yr = Cs[(2 * k2l) * CLD + n], yi = Cs[(2 * k2l + 1) * CLD + n];
          const float2 tw = ((const float2*)(ws + OFF_TW))[k2 * 64 + n1];
          const float c = tw.x, s = tw.y;
          const float o_r = yr * c + yi * s, o_i = yi * c - yr * s;
          bf16_t* dst = Y + ((((size_t)b * 128 + k2) * 512 + j) * 2) * 64 + n1;
          dst[0] = f2bf(o_r);
          dst[64] = f2bf(o_i);
        }
      });
      continue;
    }
    r -= N_F1;
    {
      const int nt4 = r & 3, mt2 = (r >> 2) & 1, b = r >> 3;
      const bf16_t* A = (const bf16_t*)(ws + OFF_DFTC) + (size_t)mt2 * 128 * 512;
      const bf16_t* Bt = (const bf16_t*)(ws + OFF_ZC) + ((size_t)b * 512 + nt4 * 128) * 512;
      auto arow = [&](int i) { return A + (size_t)i * 512; };
      auto brow = [&](int i) { return Bt + (size_t)i * 512; };
      gemm_tile(arow, brow, 512, smem, [&](const float* Cs) {
        const int i = tid >> 1, chh = tid & 1;
        const size_t off = (size_t)(NL + b * 256 + mt2 * 128 + i) * 1024 + 512 + nt4 * 128 + chh * 64;
        const bf16_t* gs = (const bf16_t*)(ws + OFF_G0) + off;
        bf16_t* dst = (bf16_t*)(ws + OFF_H) + off;
#pragma unroll
        for (int q = 0; q < 8; ++q) {
          u32x4 g4 = *(const u32x4*)(gs + q * 8);
          u32x4 pk;
#pragma unroll
          for (int e = 0; e < 4; ++e) {
            float v0 = Cs[i * CLD + chh * 64 + q * 8 + 2 * e] * lo2f(g4[e]);
            float v1 = Cs[i * CLD + chh * 64 + q * 8 + 2 * e + 1] * hi2f(g4[e]);
            pk[e] = pack2(v0, v1);
          }
          *(u32x4*)(dst + q * 8) = pk;
        }
      });
    }
  }
}

DI void attn_simple(const Params& p, char* smem, int b, int h, int q0, int key0, int nkeys) {
  char* ws = p.ws;
  const int tid = get_tid();
  float* Ks = (float*)smem;
  float* Vs = Ks + 32 * 96;
  const bf16_t* Qp = (const bf16_t*)(ws + OFF_Q) + ((size_t)(b * 8 + h) * KEYS + q0 + tid) * 96;
  const bf16_t* Kp = (const bf16_t*)(ws + OFF_K) + (size_t)(b * 8 + h) * KEYS * 96;
  const bf16_t* Vp = (const bf16_t*)(ws + OFF_VT) + (size_t)(b * 8 + h) * 64 * KEYS;
  float q[96];
#pragma unroll
  for (int qq = 0; qq < 12; ++qq) {
    u32x4 v = *(const u32x4*)(Qp + qq * 8);
#pragma unroll
    for (int e = 0; e < 4; ++e) { q[qq * 8 + 2 * e] = lo2f(v[e]); q[qq * 8 + 2 * e + 1] = hi2f(v[e]); }
  }
  float acc[64];
#pragma unroll
  for (int d = 0; d < 64; ++d) acc[d] = 0.f;
  float m = -1e30f, l = 0.f;
  for (int kt = 0; kt < nkeys; kt += 32) {
    __syncthreads();
    for (int idx = tid; idx < 32 * 96 / 2; idx += 256) {
      unsigned v = *(const unsigned*)(Kp + (size_t)(key0 + kt) * 96 + idx * 2);
      Ks[idx * 2] = lo2f(v); Ks[idx * 2 + 1] = hi2f(v);
    }
    for (int idx = tid; idx < 32 * 64; idx += 256) {
      int d = idx >> 5, kk = idx & 31;
      Vs[kk * 64 + d] = bf2f(Vp[(size_t)d * KEYS + key0 + kt + kk]);
    }
    __syncthreads();
    for (int kk = 0; kk < 32; ++kk) {
      const float4* kr = (const float4*)(Ks + kk * 96);
      float s = 0.f;
#pragma unroll
      for (int e = 0; e < 24; ++e) {
        float4 kv = kr[e];
        s += q[4 * e] * kv.x + q[4 * e + 1] * kv.y + q[4 * e + 2] * kv.z + q[4 * e + 3] * kv.w;
      }
      if (s > m) {
        const float corr = exp2f(m - s);
        l *= corr;
#pragma unroll
        for (int d = 0; d < 64; ++d) acc[d] *= corr;
        m = s;
      }
      const float pw = exp2f(s - m);
      l += pw;
      const float4* vr = (const float4*)(Vs + kk * 64);
#pragma unroll
      for (int e = 0; e < 16; ++e) {
        float4 vv = vr[e];
        acc[4 * e] += pw * vv.x; acc[4 * e + 1] += pw * vv.y; acc[4 * e + 2] += pw * vv.z; acc[4 * e + 3] += pw * vv.w;
      }
    }
  }
  const float il = 1.f / l;
  const int row = (q0 < SEQ) ? (b * 8192 + q0 + tid) : (NL + b * 256 + (q0 - SEQ) + tid);
  const size_t off = (size_t)row * 1024 + h * 64;
  const bf16_t* gs = (const bf16_t*)(ws + OFF_G0) + off;
  bf16_t* dst = (bf16_t*)(ws + OFF_H) + off;
#pragma unroll
  for (int qq = 0; qq < 8; ++qq) {
    u32x4 g4 = *(const u32x4*)(gs + qq * 8);
    u32x4 pk;
#pragma unroll
    for (int e = 0; e < 4; ++e) pk[e] = pack2(acc[qq * 8 + 2 * e] * il * lo2f(g4[e]), acc[qq * 8 + 2 * e + 1] * il * hi2f(g4[e]));
    *(u32x4*)(dst + qq * 8) = pk;
  }
  __syncthreads();
}

constexpr int AK_LD = 104, AV_LD = 72;
constexpr int AK_ELEMS = 64 * AK_LD, AV_ELEMS = 64 * AV_LD, ASTAGE = AK_ELEMS + AV_ELEMS;

DI void attn_mfma(const Params& p, char* smem, int b, int h, int q0, int key0, int nkeys, float negc) {
  char* ws = p.ws;
  const int tid = get_tid(), lane = tid & 63, wave = tid >> 6;
  const int r = lane & 31, hh = lane >> 5;
  const size_t bh = (size_t)(b * 8 + h);
  const bf16_t* Qp = (const bf16_t*)(ws + OFF_Q) + (bh * KEYS + q0 + wave * 64 + r) * 96 + hh * 8;
  bf16x8 qf[2][6];
#pragma unroll
  for (int t = 0; t < 2; ++t)
#pragma unroll
    for (int s = 0; s < 6; ++s) qf[t][s] = *(const bf16x8*)(Qp + t * 32 * 96 + 16 * s);
  const bf16_t* Kg = (const bf16_t*)(ws + OFF_K) + (bh * KEYS + key0) * 96;
  const bf16_t* Vg = (const bf16_t*)(ws + OFF_VT) + bh * 64 * KEYS + key0;
  bf16_t* S0 = (bf16_t*)smem;
  u32x4 rk[3], rv[2];
  int kdst[3], vdst[2];
  unsigned vsrc[2];
#pragma unroll
  for (int i = 0; i < 3; ++i) { int c = tid + 256 * i; kdst[i] = (c / 12) * AK_LD + (c % 12) * 8; }
#pragma unroll
  for (int i = 0; i < 2; ++i) { int c = tid + 256 * i; vdst[i] = AK_ELEMS + (c >> 3) * AV_LD + (c & 7) * 8; vsrc[i] = (unsigned)((c >> 3) * KEYS + (c & 7) * 8); }
#pragma unroll
  for (int i = 0; i < 3; ++i) rk[i] = *(const u32x4*)(Kg + (tid + 256 * i) * 8);
#pragma unroll
  for (int i = 0; i < 2; ++i) rv[i] = *(const u32x4*)(Vg + vsrc[i]);
#pragma unroll
  for (int i = 0; i < 3; ++i) *(u32x4*)(S0 + kdst[i]) = rk[i];
#pragma unroll
  for (int i = 0; i < 2; ++i) *(u32x4*)(S0 + vdst[i]) = rv[i];
  __syncthreads();
  f32x16 O[2][2];
#pragma unroll
  for (int t = 0; t < 2; ++t)
#pragma unroll
    for (int i = 0; i < 16; ++i) { O[t][0][i] = 0.f; O[t][1][i] = 0.f; }
  float lsum[2] = {0.f, 0.f};
  const int NT = nkeys >> 6;
  for (int kt = 0; kt < NT; ++kt) {
    const bf16_t* Ks = S0 + (kt & 1) * ASTAGE;
    const bf16_t* Vs = Ks + AK_ELEMS;
    if (kt + 1 < NT) {
#pragma unroll
      for (int i = 0; i < 3; ++i) rk[i] = *(const u32x4*)(Kg + (size_t)(kt + 1) * 6144 + (tid + 256 * i) * 8);
#pragma unroll
      for (int i = 0; i < 2; ++i) rv[i] = *(const u32x4*)(Vg + vsrc[i] + (kt + 1) * 64);
    }
#pragma unroll 1
    for (int sub = 0; sub < 2; ++sub) {
      f32x16 S[2];
#pragma unroll
      for (int i = 0; i < 16; ++i) { S[0][i] = negc; S[1][i] = negc; }
#pragma unroll
      for (int s = 0; s < 6; ++s) {
        const bf16x8 a = *(const bf16x8*)(Ks + (sub * 32 + r) * AK_LD + 16 * s + 8 * hh);
        S[0] = __builtin_amdgcn_mfma_f32_32x32x16_bf16(a, qf[0][s], S[0], 0, 0, 0);
        S[1] = __builtin_amdgcn_mfma_f32_32x32x16_bf16(a, qf[1][s], S[1], 0, 0, 0);
      }
      bf16x8 pb[2][2];
#pragma unroll
      for (int t = 0; t < 2; ++t) {
        float pv[16];
#pragma unroll
        for (int i = 0; i < 16; ++i) { pv[i] = __builtin_amdgcn_exp2f(S[t][i]); lsum[t] += pv[i]; }
#pragma unroll
        for (int s2 = 0; s2 < 2; ++s2) {
          u32x4 pk;
          pk[0] = pack2(pv[8 * s2 + 0], pv[8 * s2 + 1]); pk[1] = pack2(pv[8 * s2 + 2], pv[8 * s2 + 3]);
          pk[2] = pack2(pv[8 * s2 + 4], pv[8 * s2 + 5]); pk[3] = pack2(pv[8 * s2 + 6], pv[8 * s2 + 7]);
          pb[t][s2] = __builtin_bit_cast(bf16x8, pk);
        }
      }
#pragma unroll
      for (int s2 = 0; s2 < 2; ++s2)
#pragma unroll
        for (int dt = 0; dt < 2; ++dt) {
          const bf16_t* vp = Vs + (dt * 32 + r) * AV_LD + sub * 32 + 16 * s2 + 4 * hh;
          u32x2 lo = *(const u32x2*)vp;
          u32x2 hi = *(const u32x2*)(vp + 8);
          u32x4 va4; va4[0] = lo[0]; va4[1] = lo[1]; va4[2] = hi[0]; va4[3] = hi[1];
          const bf16x8 va = __builtin_bit_cast(bf16x8, va4);
          O[0][dt] = __builtin_amdgcn_mfma_f32_32x32x16_bf16(va, pb[0][s2], O[0][dt], 0, 0, 0);
          O[1][dt] = __builtin_amdgcn_mfma_f32_32x32x16_bf16(va, pb[1][s2], O[1][dt], 0, 0, 0);
        }
    }
    if (kt + 1 < NT) {
      bf16_t* Sn = S0 + ((kt + 1) & 1) * ASTAGE;
#pragma unroll
      for (int i = 0; i < 3; ++i) *(u32x4*)(Sn + kdst[i]) = rk[i];
#pragma unroll
      for (int i = 0; i < 2; ++i) *(u32x4*)(Sn + vdst[i]) = rv[i];
    }
    __syncthreads();
  }
#pragma unroll
  for (int t = 0; t < 2; ++t) {
    const float ltot = lsum[t] + __shfl_xor(lsum[t], 32);
    const float il = 1.f / ltot;
    const int pos = q0 + wave * 64 + t * 32 + r;
    const int row = (q0 < SEQ) ? (b * 8192 + pos) : (NL + b * 256 + pos - SEQ);
    const size_t off = (size_t)row * 1024 + h * 64;
    const bf16_t* gs = (const bf16_t*)(ws + OFF_G0) + off;
    bf16_t* dst = (bf16_t*)(ws + OFF_H) + off;
#pragma unroll
    for (int dt = 0; dt < 2; ++dt)
#pragma unroll
      for (int g = 0; g < 4; ++g) {
        const int d0 = dt * 32 + 8 * g + 4 * hh;
        u32x2 g2 = *(const u32x2*)(gs + d0);
        u32x2 o2;
        o2[0] = pack2(O[t][dt][4 * g] * il * lo2f(g2[0]), O[t][dt][4 * g + 1] * il * hi2f(g2[0]));
        o2[1] = pack2(O[t][dt][4 * g + 2] * il * lo2f(g2[1]), O[t][dt][4 * g + 3] * il * hi2f(g2[1]));
        *(u32x2*)(dst + d0) = o2;
      }
  }
}

DI void phase_attn(const Params& p, char* smem) {
  char* ws = p.ws;
  const int tid = get_tid();
  float negc;
  {
    float mq = 0.f, mk = 0.f;
    for (int e = 0; e < 96; ++e) { mq = fmaxf(mq, fabsf(p.e_q_head_norm[e])); mk = fmaxf(mk, fabsf(p.e_k_head_norm[e])); }
    negc = -(9.797958971132712f * 1.4426950408889634f) * mq * mk;
  }
  {
    const int xcd = blockIdx.x & 7, j = blockIdx.x >> 3, nper = gridDim.x >> 3;
    if (nper > 0 && (gridDim.x & 7) == 0) {
      for (int li = j; li < 128; li += nper) {
        const int pair = (li >> 5) * 8 + xcd, qb = li & 31;
        attn_mfma(p, smem, pair >> 3, pair & 7, qb * 256, 0, KEYS, negc);
      }
    } else {
      for (int it = blockIdx.x; it < 1024; it += gridDim.x) attn_mfma(p, smem, it >> 8, (it >> 5) & 7, (it & 31) * 256, 0, KEYS, negc);
    }
  }
  constexpr int N_AL = 0, N_AC = 32, N_F2 = 2048;
  for (int it = blockIdx.x; it < N_AL + N_AC + N_F2; it += gridDim.x) {
    if (it < N_AL + N_AC) {
      const int r = it - N_AL;
      attn_mfma(p, smem, r >> 3, r & 7, SEQ, SEQ, CTX, negc);
      continue;
    }
    {
      const int r = it - N_AL - N_AC;
      const int jb = r & 3, k2 = (r >> 2) & 127, b = r >> 9;
      const bf16_t* A = (const bf16_t*)(ws + OFF_YT) + (((size_t)b * 128 + k2) * 512 + jb * 128) * 128;
      const bf16_t* Bt = (const bf16_t*)(ws + OFF_DFT64);
      auto arow = [&](int i) { return A + (size_t)i * 128; };
      auto brow = [&](int i) { return Bt + (size_t)i * 128; };
      gemm_tile(arow, brow, 128, smem, [&](const float* Cs) {
#pragma unroll
        for (int q = 0; q < 4; ++q) {
          const int cc = tid + 256 * q;
          const int n = cc >> 4, ch = cc & 15;
          const size_t off = (size_t)(b * 8192 + 128 * n + k2) * 1024 + 512 + jb * 128 + ch * 8;
          const u32x4 g4 = *(const u32x4*)((const bf16_t*)(ws + OFF_G0) + off);
          u32x4 pk;
#pragma unroll
          for (int e = 0; e < 4; ++e) {
            const float v0 = Cs[(ch * 8 + 2 * e) * CLD + n] * lo2f(g4[e]);
            const float v1 = Cs[(ch * 8 + 2 * e + 1) * CLD + n] * hi2f(g4[e]);
            pk[e] = pack2(v0, v1);
          }
          *(u32x4*)((bf16_t*)(ws + OFF_H) + off) = pk;
        }
      });
    }
  }
}

template <int CTRL>
DI float dpp_xadd(float x) {
  int t = __builtin_amdgcn_update_dpp(0, __builtin_bit_cast(int, x), CTRL, 0xF, 0xF, true);
  return x + __builtin_bit_cast(float, t);
}
DI void phase_outproj(const Params& p, char* smem, int layer) {
  char* ws = p.ws;
  const int tid = get_tid();
  const bf16_t* A = (const bf16_t*)(ws + OFF_H);
  const bf16_t* W = (const bf16_t*)(ws + (layer == 0 ? OFF_WOUTE : OFF_WOUTO));
  const float* mod = (const float*)(ws + OFF_MOD) + layer * 5 * 3072;
  const int nmt = layer == 0 ? 264 : 256;
  auto do_tile = [&](int mt, int nt) {
    auto arow = [&](int i) { return A + (size_t)(mt * 128 + i) * 1024; };
    auto brow = [&](int i) { return W + (size_t)(nt * 128 + i) * 1024; };
    gemm_tile(arow, brow, 1024, smem, [&](const float* Cs) {
      const int c4 = (tid & 31) * 4, r0 = tid >> 5;
      const int n = nt * 128 + c4;
      const int row0 = mt * 128;
      const bool lat = row0 < NL;
      const float4 gm = *(const float4*)(mod + (lat ? (row0 >> 13) : 4) * 3072 + 2048 + n);
      const float* xin = lat ? ((layer == 0 ? p.x : p.out) + (size_t)row0 * 1024 + n) : (p.ctx + (size_t)(row0 - NL) * 1024 + n);
      float* xo = lat ? (p.out + (size_t)row0 * 1024 + n) : ((float*)(ws + OFF_CTX1) + (size_t)(row0 - NL) * 1024 + n);
      float4 gs = make_float4(0.f, 0.f, 0.f, 0.f);
      if (layer == 0) {
        const float4 g1 = *(const float4*)(p.norm_g + 1024 + n);
        const float4 s1 = *(const float4*)(mod + 5 * 3072 + (lat ? (row0 >> 13) : 4) * 3072 + 1024 + n);
        gs = make_float4(g1.x * (1.f + s1.x), g1.y * (1.f + s1.y), g1.z * (1.f + s1.z), g1.w * (1.f + s1.w));
      }
#pragma unroll 4
      for (int q = 0; q < 16; ++q) {
        const int i = r0 + 8 * q;
        float4 xv = *(const float4*)(xin + (size_t)i * 1024);
        xv.x += gm.x * Cs[i * CLD + c4]; xv.y += gm.y * Cs[i * CLD + c4 + 1];
        xv.z += gm.z * Cs[i * CLD + c4 + 2]; xv.w += gm.w * Cs[i * CLD + c4 + 3];
        *(float4*)(xo + (size_t)i * 1024) = xv;
        if (layer == 0) {
          u32x2 a2;
          a2[0] = pack2(xv.x * gs.x, xv.y * gs.y); a2[1] = pack2(xv.z * gs.z, xv.w * gs.w);
          *(u32x2*)((bf16_t*)(ws + OFF_A1) + (size_t)(row0 + i) * 1024 + n) = a2;
          float ss = xv.x * xv.x + xv.y * xv.y + xv.z * xv.z + xv.w * xv.w;
          ss = dpp_xadd<0xB1>(ss); ss = dpp_xadd<0x4E>(ss); ss = dpp_xadd<0x141>(ss); ss = dpp_xadd<0x140>(ss);
          ss += __shfl_xor(ss, 16);
          if ((tid & 31) == 0) ((float*)(ws + OFF_SSQ))[(size_t)(row0 + i) * 8 + nt] = ss;
        }
      }
    });
  };
  tile_walk(32, 8, do_tile);
  for (int it = blockIdx.x; it < (nmt - 256) * 8; it += gridDim.x) do_tile(256 + (it >> 3), it & 7);
}

DI void phase_inproj_o(const Params& p, char* smem) {
  char* ws = p.ws;
  const int tid = get_tid();
  const bf16_t* hb = (const bf16_t*)(ws + OFF_A1);
  const bf16_t* W = (const bf16_t*)(ws + OFF_WINO);
  bf16_t* U1 = (bf16_t*)(ws + OFF_U1);
  float* rstat = (float*)(smem + SMEM_MAIN);
  auto do_tile = [&](int mt, int nt) {
    if (tid < 128) {
      const float4* sp = (const float4*)((const float*)(ws + OFF_SSQ) + (size_t)(mt * 128 + tid) * 8);
      const float4 s0 = sp[0], s1 = sp[1];
      const float ss = ((s0.x + s0.y) + (s0.z + s0.w)) + ((s1.x + s1.y) + (s1.z + s1.w));
      rstat[tid] = rsqrtf(ss * (1.f / 1024.f) + EPS);
    }
    const float* bias = (const float*)(ws + OFF_BIAS1) + (mt < 256 ? (mt >> 6) : 4) * 4352 + nt * 128;
    auto arow = [&](int i) { return hb + (size_t)(mt * 128 + i) * 1024; };
    auto brow = [&](int i) { return W + (size_t)(nt * 128 + i) * 1024; };
    gemm_tile(arow, brow, 1024, smem, [&](const float* Cs) {
      const bool do_silu = nt >= 26;
#pragma unroll
      for (int q = 0; q < 8; ++q) {
        const int c = tid + 256 * q;
        const int i = c >> 4, ch = c & 15;
        const float rs = rstat[i];
        const float4 b0 = *(const float4*)(bias + ch * 8), b1 = *(const float4*)(bias + ch * 8 + 4);
        const float bb[8] = {b0.x, b0.y, b0.z, b0.w, b1.x, b1.y, b1.z, b1.w};
        float v[8];
#pragma unroll
        for (int e = 0; e < 8; ++e) { v[e] = Cs[i * CLD + ch * 8 + e] * rs + bb[e]; if (do_silu) v[e] = siluf(v[e]); }
        u32x4 pk;
        pk[0] = pack2(v[0], v[1]); pk[1] = pack2(v[2], v[3]); pk[2] = pack2(v[4], v[5]); pk[3] = pack2(v[6], v[7]);
        *(u32x4*)(U1 + (size_t)(mt * 128 + i) * 4352 + nt * 128 + ch * 8) = pk;
      }
    });
  };
  tile_walk(32, 34, do_tile);
  for (int it = blockIdx.x; it < 8 * 18; it += gridDim.x) do_tile(256 + it / 18, it % 18);
}

DI float red8(float x) { x = dpp_xadd<0xB1>(x); x = dpp_xadd<0x4E>(x); x = dpp_xadd<0x141>(x); return x; }
DI float red16(float x) { x = red8(x); x = dpp_xadd<0x140>(x); return x; }
DI float fast_tanh(float x) { float e = __expf(2.f * x); return 1.f - 2.f * __builtin_amdgcn_rcpf(1.f + e); }

DI void phase_scan_fallback(const Params& p, char* smem) {
  char* ws = p.ws;
  const int tid = get_tid(), lane = tid & 63, wave = tid >> 6;
  const int r31 = lane & 31, hh = lane >> 5;
  const bf16_t* U1 = (const bf16_t*)(ws + OFF_U1);
  constexpr int L = 32;
  float* sw_ = (float*)smem;
  float* skk = sw_ + L * 64;
  float* sbb = skk + L * 64;
  float* skd = sbb + L * 64;
  float* sr = skd + L * 64;
  float* sv = sr + L * 64;
  bf16_t* t1b = (bf16_t*)(sv + L * 64);
  bf16_t* t2b = t1b + L * 72;
  float* invn = (float*)(t2b + L * 72);
  float* ys = invn + L;
  float* yp = ys + L * 32;
  const bool std_grid = gridDim.x == 512;
  for (int it0 = blockIdx.x; it0 < (std_grid ? 512 : 256); it0 += gridDim.x) {
    int it = it0;
    if (std_grid) {
      const int xcd = it0 & 7, j = it0 >> 3;
      if ((j & 1) != (j >> 5)) continue;
      const int idx = (j < 32) ? (j >> 1) : (16 + ((j - 32) >> 1));
      it = (((idx >> 2) * 8 + xcd) << 2) | (idx & 3);
    }
    const int vq = it & 1, dir = (it >> 1) & 1, h = (it >> 2) & 15, b = it >> 6;
    bf16_t* Yd = (bf16_t*)(ws + (dir == 0 ? OFF_H : OFF_Y1));
    float* bsd = (float*)(ws + OFF_BS) + (size_t)dir * NL * 16;
    float S[8] = {0.f, 0.f, 0.f, 0.f, 0.f, 0.f, 0.f, 0.f};
    const int c = tid & 63, tg = tid >> 6;
    const int hc = h * 64 + c;
    const float w0c = p.o_w0[dir * 1024 + hc], a0c = p.o_a0[dir * 1024 + hc];
    const float kkc = p.o_k_k[hc], kac = p.o_k_a[hc];
    const int cols[5] = {hc, 1024 + hc, 2304 + hc, 2048 + dir * 64 + c, 2176 + dir * 64 + c};
    float swc[5][3];
#pragma unroll
    for (int a = 0; a < 5; ++a)
#pragma unroll
      for (int j = 0; j < 3; ++j) swc[a][j] = p.o_shift_w[j * 3328 + cols[a]];
    const int mat = wave >> 1, nt = wave & 1;
    bf16x8 bfr[4];
    {
      const float* lw = (mat == 0 ? p.o_w2 : p.o_a2) + (size_t)dir * 64 * 1024 + h * 64 + nt * 32 + r31;
#pragma unroll
      for (int s = 0; s < 4; ++s) {
        u32x4 pk;
#pragma unroll
        for (int e = 0; e < 4; ++e) {
          const int k0 = 16 * s + 8 * hh + 2 * e;
          pk[e] = pack2(lw[(size_t)k0 * 1024], lw[(size_t)(k0 + 1) * 1024]);
        }
        bfr[s] = __builtin_bit_cast(bf16x8, pk);
      }
    }
    const int rt = tid >> 3, part = tid & 7;
    float kk8[8], rk8[8];
#pragma unroll
    for (int e = 0; e < 8; ++e) { kk8[e] = p.o_k_k[h * 64 + part * 8 + e]; rk8[e] = p.o_r_k[h * 64 + part * 8 + e]; }
    const int vrow = tid >> 3, kq = tid & 7;
    float u[5][10];
    unsigned raw[5][10];
    auto issue_chunk = [&](int g) {
      const int seg = g < 8 ? 0 : 1;
      const int ci = seg ? g - 8 : g;
      const int T = seg == 0 ? CTX : SEQ;
      const int nch = T / L;
      const size_t rowbase = seg == 0 ? (size_t)(NL + b * CTX) : (size_t)b * SEQ;
      const int c0 = (dir == 0 ? ci : nch - 1 - ci) * L;
#pragma unroll
      for (int a = 0; a < 5; ++a) {
        const bf16_t* up = U1 + rowbase * 4352 + cols[a] - ((a == 2 && seg == 0) ? 1024 : 0);
#pragma unroll
        for (int q = 0; q < 10; ++q) {
          const int t = c0 + tg * 8 - 1 + q;
          const int tc = min(max(t, 0), T - 1);
          raw[a][q] = up[(size_t)tc * 4352];
        }
      }
    };
    auto finish_chunk = [&](int g) {
      const int seg = g < 8 ? 0 : 1;
      const int ci = seg ? g - 8 : g;
      const int T = seg == 0 ? CTX : SEQ;
      const int nch = T / L;
      const int c0 = (dir == 0 ? ci : nch - 1 - ci) * L;
#pragma unroll
      for (int a = 0; a < 5; ++a)
        asm volatile("" : "+v"(raw[a][0]), "+v"(raw[a][1]), "+v"(raw[a][2]), "+v"(raw[a][3]), "+v"(raw[a][4]), "+v"(raw[a][5]),
                     "+v"(raw[a][6]), "+v"(raw[a][7]), "+v"(raw[a][8]), "+v"(raw[a][9]));
#pragma unroll
      for (int a = 0; a < 5; ++a)
#pragma unroll
        for (int q = 0; q < 10; ++q) {
          const int t = c0 + tg * 8 - 1 + q;
          const bool ok = (t >= 0) && (t < T) && !(a == 2 && seg == 0);
          u[a][q] = ok ? __uint_as_float(raw[a][q] << 16) : 0.f;
        }
    };
    issue_chunk(0);
    for (int g = 0; g < 264; ++g) {
      {
        const int seg = g < 8 ? 0 : 1;
        const int ci = seg ? g - 8 : g;
        const int T = seg == 0 ? CTX : SEQ;
        const size_t rowbase = seg == 0 ? (size_t)(NL + b * CTX) : (size_t)b * SEQ;
        const bool with_out = seg == 1;
        const int nch = T / L;
        const int c0 = (dir == 0 ? ci : nch - 1 - ci) * L;
        finish_chunk(g);
#pragma unroll
        for (int a = 0; a < 5; ++a) {
#pragma unroll
          for (int tt = 0; tt < 8; ++tt) {
            const float z = swc[a][0] * u[a][tt] + swc[a][1] * u[a][tt + 1] + swc[a][2] * u[a][tt + 2];
            const int li = (tg * 8 + tt) * 64 + c;
            if (a == 0) skk[li] = z;
            else if (a == 1) sv[li] = z;
            else if (a == 2) sr[li] = z;
            else if (a == 3) t1b[(tg * 8 + tt) * 72 + c] = f2bf(fast_tanh(z));
            else t2b[(tg * 8 + tt) * 72 + c] = f2bf(z);
          }
        }
        __syncthreads();
        {
          f32x16 acc;
#pragma unroll
          for (int i = 0; i < 16; ++i) acc[i] = 0.f;
          const bf16_t* ta = (mat == 0 ? t1b : t2b) + r31 * 72 + 8 * hh;
#pragma unroll
          for (int s = 0; s < 4; ++s) acc = __builtin_amdgcn_mfma_f32_32x32x16_bf16(*(const bf16x8*)(ta + 16 * s), bfr[s], acc, 0, 0, 0);
          float* dstm = (mat == 0 ? sw_ : sbb) + nt * 32 + r31;
#pragma unroll
          for (int i = 0; i < 16; ++i) dstm[((i & 3) + 8 * (i >> 2) + 4 * hh) * 64] = acc[i];
        }
        __syncthreads();
#pragma unroll
        for (int tt = 0; tt < 8; ++tt) {
          const int li = (tg * 8 + tt) * 64 + c;
          const float wr = w0c + sw_[li];
          const float dec = __expf(-0.6065306597126334f * sigm(wr));
          const float av = sigm(a0c + sbb[li]);
          const float zk = skk[li];
          sw_[li] = dec; sbb[li] = av; skd[li] = zk * (1.f + (av - 1.f) * kac);
        }
        __syncthreads();
        {
          float ss = 0.f, bs = 0.f;
#pragma unroll
          for (int e = 0; e < 8; ++e) {
            const int li = rt * 64 + part * 8 + e;
            const float kkv = skk[li] * kk8[e];
            ss += kkv * kkv;
            if (with_out) bs += sr[li] * skd[li] * rk8[e];
          }
          ss = red8(ss);
          bs = red8(bs);
          if (part == 0) {
            invn[rt] = 1.f / fmaxf(sqrtf(ss), 1e-12f);
            if (with_out && vq == 0) bsd[(rowbase + c0 + rt) * 16 + h] = bs;
          }
        }
        __syncthreads();
#pragma unroll
        for (int tt = 0; tt < 8; ++tt) {
          const int li = (tg * 8 + tt) * 64 + c;
          const float kkn = skk[li] * kkc * invn[tg * 8 + tt];
          skk[li] = kkn; sbb[li] = kkn * sbb[li];
        }
        __syncthreads();
        if (g + 1 < 264) issue_chunk(g + 1);
        {
          float4 w4n[2], k4n[2], b4n[2], d4n[2], r4n[2];
          float vvn;
          auto ldtok = [&](int s) {
            const int tl = dir == 0 ? s : L - 1 - s;
#pragma unroll
            for (int q = 0; q < 2; ++q) {
              w4n[q] = *(const float4*)(sw_ + tl * 64 + kq * 8 + q * 4);
              k4n[q] = *(const float4*)(skk + tl * 64 + kq * 8 + q * 4);
              b4n[q] = *(const float4*)(sbb + tl * 64 + kq * 8 + q * 4);
              d4n[q] = *(const float4*)(skd + tl * 64 + kq * 8 + q * 4);
              r4n[q] = *(const float4*)(sr + tl * 64 + kq * 8 + q * 4);
            }
            vvn = sv[tl * 64 + vq * 32 + vrow];
          };
          ldtok(0);
          {
#pragma unroll 2
            for (int s = 0; s < L; ++s) {
              const int j8 = s & 7, s8 = s & ~7;
              float w8[8], k8[8], b8[8], d8[8], r8[8];
#pragma unroll
              for (int q = 0; q < 2; ++q) {
                w8[4 * q] = w4n[q].x; w8[4 * q + 1] = w4n[q].y; w8[4 * q + 2] = w4n[q].z; w8[4 * q + 3] = w4n[q].w;
                k8[4 * q] = k4n[q].x; k8[4 * q + 1] = k4n[q].y; k8[4 * q + 2] = k4n[q].z; k8[4 * q + 3] = k4n[q].w;
                b8[4 * q] = b4n[q].x; b8[4 * q + 1] = b4n[q].y; b8[4 * q + 2] = b4n[q].z; b8[4 * q + 3] = b4n[q].w;
                d8[4 * q] = d4n[q].x; d8[4 * q + 1] = d4n[q].y; d8[4 * q + 2] = d4n[q].z; d8[4 * q + 3] = d4n[q].w;
                r8[4 * q] = r4n[q].x; r8[4 * q + 1] = r4n[q].y; r8[4 * q + 2] = r4n[q].z; r8[4 * q + 3] = r4n[q].w;
              }
              const float vv = vvn;
              if (s + 1 < L) ldtok(s + 1);
              float sa0 = 0.f, sa1 = 0.f, pre[8];
#pragma unroll
              for (int i = 0; i < 8; i += 2) { sa0 += S[i] * k8[i]; sa1 += S[i + 1] * k8[i + 1]; }
#pragma unroll
              for (int i = 0; i < 8; ++i) pre[i] = S[i] * w8[i] + vv * d8[i];
              const float sa = red8(sa0 + sa1);
#pragma unroll
              for (int i = 0; i < 8; ++i) S[i] = pre[i] - sa * b8[i];
              if (with_out) {
                float y0 = 0.f, y1 = 0.f;
#pragma unroll
                for (int i = 0; i < 8; i += 2) { y0 += S[i] * r8[i]; y1 += S[i + 1] * r8[i + 1]; }
                yp[j8 * 256 + tid] = y0 + y1;
              }
            if (with_out && j8 == 7) {
              const int jt = lane >> 3, rw = lane & 7;
              const float4 p0 = *(const float4*)(yp + jt * 256 + wave * 64 + rw * 8);
              const float4 p1 = *(const float4*)(yp + jt * 256 + wave * 64 + rw * 8 + 4);
              const float y = ((p0.x + p0.y) + (p0.z + p0.w)) + ((p1.x + p1.y) + (p1.z + p1.w));
              const int sg = s8 + jt;
              const int tlg = dir == 0 ? sg : L - 1 - sg;
              ys[tlg * 32 + wave * 8 + rw] = y;
            }
            }
          }
        }
        __syncthreads();
        if (with_out) {
          const int tok = tid >> 3, pr = (tid & 7) * 4;
          u32x2 o2;
          o2[0] = pack2(ys[tok * 32 + pr], ys[tok * 32 + pr + 1]);
          o2[1] = pack2(ys[tok * 32 + pr + 2], ys[tok * 32 + pr + 3]);
          *(u32x2*)(Yd + (rowbase + c0 + tok) * 1024 + h * 64 + vq * 32 + pr) = o2;
        }
      }
    }
    __syncthreads();
  }
}

constexpr int NSLOT = 16, NGRP = 8;
constexpr int SLOT_U = 1792;
DI unsigned ld_flag(const unsigned* f) { return __hip_atomic_load(f, __ATOMIC_RELAXED, __HIP_MEMORY_SCOPE_AGENT); }
DI void st_flag(unsigned* f, unsigned v) { __hip_atomic_store(f, v, __ATOMIC_RELAXED, __HIP_MEMORY_SCOPE_AGENT); }
DI void wait_flags(const unsigned* f0, const unsigned* f1, unsigned want) {
  if (threadIdx.x == 0) {
    unsigned spins = 0;
    while ((ld_flag(f0) < want || ld_flag(f1) < want) && spins < (1u << 21)) { __builtin_amdgcn_s_sleep(2); ++spins; }
    __builtin_amdgcn_fence(__ATOMIC_ACQUIRE, "agent");
    asm volatile("s_waitcnt vmcnt(0)" ::: "memory");
  }
  __syncthreads();
}

DI void wait_flags_nofence(const unsigned* f0, const unsigned* f1, unsigned want) {
  if (threadIdx.x == 0) {
    unsigned spins = 0;
    while ((ld_flag(f0) < want || ld_flag(f1) < want) && spins < (1u << 21)) { __builtin_amdgcn_s_sleep(2); ++spins; }
  }
  __syncthreads();
}

DI void wait_flags2(const unsigned* f0, unsigned want0, const unsigned* f1, unsigned want1) {
  if (threadIdx.x == 0) {
    unsigned spins = 0;
    while ((ld_flag(f0) < want0 || ld_flag(f1) < want1) && spins < (1u << 21)) { __builtin_amdgcn_s_sleep(2); ++spins; }
    __builtin_amdgcn_fence(__ATOMIC_ACQUIRE, "agent");
    asm volatile("s_waitcnt vmcnt(0)" ::: "memory");
  }
  __syncthreads();
}

DI void phase_scan(const Params& p, char* smem) {
  if (gridDim.x != 512) { phase_scan_fallback(p, smem); return; }
  char* ws = p.ws;
  const int tid = get_tid(), lane = tid & 63, wave = tid >> 6;
  const int r31 = lane & 31, hh = lane >> 5;
  const bf16_t* U1 = (const bf16_t*)(ws + OFF_U1);
  constexpr int L = 32;
  float* sw_ = (float*)smem;
  float* skk = sw_ + L * 64;
  float* sbb = skk + L * 64;
  float* skd = sbb + L * 64;
  float* sr = skd + L * 64;
  float* sv = sr + L * 64;
  bf16_t* t1b = (bf16_t*)(sv + L * 64);
  bf16_t* t2b = t1b + L * 72;
  float* invn = (float*)(t2b + L * 72);
  float* ys = invn + L;
  float* yp = ys + L * 32;
  const int xcd = blockIdx.x & 7, j = blockIdx.x >> 3;
  const bool consumer = (j & 1) == (j >> 5);
  const int idx = (j < 32) ? (j >> 1) : (16 + ((j - 32) >> 1));
  int vq, dir, h, b;
  if (consumer) { vq = idx & 1; dir = (idx >> 1) & 1; const int bh = (idx >> 2) * 8 + xcd; h = bh & 15; b = bh >> 4; }
  else { vq = 0; dir = (idx >> 1) & 1; const int bh = (idx >> 2) * 8 + xcd; h = bh & 15; b = bh >> 4; }
  const int par = idx & 1;
  const int seq = ((b * 16 + h) << 1) | dir;
  unsigned* f_prod0 = (unsigned*)(ws + OFF_FLG) + (seq * 2) * 16;
  unsigned* f_prod1 = f_prod0 + 16;
  unsigned* f_cons0 = (unsigned*)(ws + OFF_FLG + 16384) + (seq * 2) * 16;
  unsigned* f_cons1 = f_cons0 + 16;
  u32x4* ring = (u32x4*)(ws + OFF_RING) + (size_t)seq * NSLOT * SLOT_U;
  if (!consumer) {
    bf16_t* Yd = (bf16_t*)(ws + (dir == 0 ? OFF_H : OFF_Y1));
    float* bsd = (float*)(ws + OFF_BS) + (size_t)dir * NL * 16;
    const int c = tid & 63, tg = tid >> 6;
    const int hc = h * 64 + c;
    const float w0c = p.o_w0[dir * 1024 + hc], a0c = p.o_a0[dir * 1024 + hc];
    const float kkc = p.o_k_k[hc], kac = p.o_k_a[hc];
    const int cols[5] = {hc, 1024 + hc, 2304 + hc, 2048 + dir * 64 + c, 2176 + dir * 64 + c};
    float swc[5][3];
#pragma unroll
    for (int a = 0; a < 5; ++a)
#pragma unroll
      for (int j = 0; j < 3; ++j) swc[a][j] = p.o_shift_w[j * 3328 + cols[a]];
    const int mat = wave >> 1, nt = wave & 1;
    bf16x8 bfr[4];
    {
      const float* lw = (mat == 0 ? p.o_w2 : p.o_a2) + (size_t)dir * 64 * 1024 + h * 64 + nt * 32 + r31;
#pragma unroll
      for (int s = 0; s < 4; ++s) {
        u32x4 pk;
#pragma unroll
        for (int e = 0; e < 4; ++e) {
          const int k0 = 16 * s + 8 * hh + 2 * e;
          pk[e] = pack2(lw[(size_t)k0 * 1024], lw[(size_t)(k0 + 1) * 1024]);
        }
        bfr[s] = __builtin_bit_cast(bf16x8, pk);
      }
    }
    const int rt = tid >> 3, part = tid & 7;
    float kk8[8], rk8[8];
#pragma unroll
    for (int e = 0; e < 8; ++e) { kk8[e] = p.o_k_k[h * 64 + part * 8 + e]; rk8[e] = p.o_r_k[h * 64 + part * 8 + e]; }
    float u[5][10];
    unsigned raw[5][10];
    auto issue_chunk = [&](int g) {
      const int seg = g < 8 ? 0 : 1;
      const int ci = seg ? g - 8 : g;
      const int T = seg == 0 ? CTX : SEQ;
      const int nch = T / L;
      const size_t rowbase = seg == 0 ? (size_t)(NL + b * CTX) : (size_t)b * SEQ;
      const int c0 = (dir == 0 ? ci : nch - 1 - ci) * L;
#pragma unroll
      for (int a = 0; a < 5; ++a) {
        const bf16_t* up = U1 + rowbase * 4352 + cols[a] - ((a == 2 && seg == 0) ? 1024 : 0);
#pragma unroll
        for (int q = 0; q < 10; ++q) {
          const int t = c0 + tg * 8 - 1 + q;
          const int tc = min(max(t, 0), T - 1);
          raw[a][q] = up[(size_t)tc * 4352];
        }
      }
    };
    auto finish_chunk = [&](int g) {
      const int seg = g < 8 ? 0 : 1;
      const int ci = seg ? g - 8 : g;
      const int T = seg == 0 ? CTX : SEQ;
      const int nch = T / L;
      const int c0 = (dir == 0 ? ci : nch - 1 - ci) * L;
#pragma unroll
      for (int a = 0; a < 5; ++a)
        asm volatile("" : "+v"(raw[a][0]), "+v"(raw[a][1]), "+v"(raw[a][2]), "+v"(raw[a][3]), "+v"(raw[a][4]), "+v"(raw[a][5]),
                     "+v"(raw[a][6]), "+v"(raw[a][7]), "+v"(raw[a][8]), "+v"(raw[a][9]));
#pragma unroll
      for (int a = 0; a < 5; ++a)
#pragma unroll
        for (int q = 0; q < 10; ++q) {
          const int t = c0 + tg * 8 - 1 + q;
          const bool ok = (t >= 0) && (t < T) && !(a == 2 && seg == 0);
          u[a][q] = ok ? __uint_as_float(raw[a][q] << 16) : 0.f;
        }
    };
    issue_chunk(par);
    for (int g = par; g < 264; g += 2) {
      const int seg = g < 8 ? 0 : 1;
      const int ci = seg ? g - 8 : g;
      const int T = seg == 0 ? CTX : SEQ;
      const size_t rowbase = seg == 0 ? (size_t)(NL + b * CTX) : (size_t)b * SEQ;
      const bool with_out = seg == 1;
      const int nch = T / L;
      const int c0 = (dir == 0 ? ci : nch - 1 - ci) * L;
      (void)T; (void)rowbase; (void)nch; (void)c0;
        finish_chunk(g);
#pragma unroll
        for (int a = 0; a < 5; ++a) {
#pragma unroll
          for (int tt = 0; tt < 8; ++tt) {
            const float z = swc[a][0] * u[a][tt] + swc[a][1] * u[a][tt + 1] + swc[a][2] * u[a][tt + 2];
            const int li = (tg * 8 + tt) * 64 + c;
            if (a == 0) skk[li] = z;
            else if (a == 1) sv[li] = z;
            else if (a == 2) sr[li] = z;
            else if (a == 3) t1b[(tg * 8 + tt) * 72 + c] = f2bf(fast_tanh(z));
            else t2b[(tg * 8 + tt) * 72 + c] = f2bf(z);
          }
        }
        __syncthreads();
        {
          f32x16 acc;
#pragma unroll
          for (int i = 0; i < 16; ++i) acc[i] = 0.f;
          const bf16_t* ta = (mat == 0 ? t1b : t2b) + r31 * 72 + 8 * hh;
#pragma unroll
          for (int s = 0; s < 4; ++s) acc = __builtin_amdgcn_mfma_f32_32x32x16_bf16(*(const bf16x8*)(ta + 16 * s), bfr[s], acc, 0, 0, 0);
          float* dstm = (mat == 0 ? sw_ : sbb) + nt * 32 + r31;
#pragma unroll
          for (int i = 0; i < 16; ++i) dstm[((i & 3) + 8 * (i >> 2) + 4 * hh) * 64] = acc[i];
        }
        __syncthreads();
#pragma unroll
        for (int tt = 0; tt < 8; ++tt) {
          const int li = (tg * 8 + tt) * 64 + c;
          const float wr = w0c + sw_[li];
          const float av = sigm(a0c + sbb[li]);
          const float zk = skk[li];
          sw_[li] = -0.6065306597126334f * sigm(wr);
          sbb[li] = av; skd[li] = zk * (1.f + (av - 1.f) * kac);
        }
        __syncthreads();
        {
          float ss = 0.f, bs = 0.f;
#pragma unroll
          for (int e = 0; e < 8; ++e) {
            const int li = rt * 64 + part * 8 + e;
            const float kkv = skk[li] * kk8[e];
            ss += kkv * kkv;
            if (with_out) bs += sr[li] * skd[li] * rk8[e];
          }
          ss = red8(ss);
          bs = red8(bs);
          if (part == 0) {
            invn[rt] = 1.f / fmaxf(sqrtf(ss), 1e-12f);
            if (with_out) bsd[(rowbase + c0 + rt) * 16 + h] = bs;
          }
        }
        __syncthreads();
        {
          float lw8[8], cw8[8];
          float run = 0.f;
#pragma unroll
          for (int q = 0; q < 8; ++q) {
            const int tt = dir == 0 ? q : 7 - q;
            lw8[tt] = sw_[(tg * 8 + tt) * 64 + c];
            run += lw8[tt];
            cw8[tt] = run;
          }
          ys[tg * 64 + c] = run;
          __syncthreads();
          float pre = 0.f, tot = 0.f;
#pragma unroll
          for (int q = 0; q < 4; ++q) { const float gq = ys[q * 64 + c]; tot += gq; if (dir == 0 ? (q < tg) : (q > tg)) pre += gq; }
#pragma unroll
          for (int tt = 0; tt < 8; ++tt) {
            const int li = (tg * 8 + tt) * 64 + c;
            const float cw = pre + cw8[tt];
            const float epos = __expf(cw), eprev = __expf(cw - lw8[tt]);
            const float eneg = __builtin_amdgcn_rcpf(epos);
            const float kkn = skk[li] * kkc * invn[tg * 8 + tt];
            skk[li] = kkn * eprev;
            sbb[li] = kkn * sbb[li] * eneg;
            skd[li] = skd[li] * eneg;
            sr[li] = with_out ? sr[li] * epos : 0.f;
          }
          __syncthreads();
          if (tg == 0) sw_[c] = __expf(tot);
        }
        __syncthreads();
      if (g + 2 < 264) issue_chunk(g + 2);
      if (g >= NSLOT) wait_flags_nofence(f_cons0, f_cons1, (unsigned)(g - NSLOT + 1));
      {
        u32x4* dst = ring + (g % NSLOT) * SLOT_U;
        const u32x4* src = (const u32x4*)smem;
        if (tid < 16) dst[tid] = src[tid];
#pragma unroll
        for (int a = 1; a < 6; ++a) {
          const float4 f0 = *(const float4*)(smem + a * 8192 + tid * 32);
          const float4 f1 = *(const float4*)(smem + a * 8192 + tid * 32 + 16);
          u32x4 pk;
          pk[0] = pack2(f0.x, f0.y); pk[1] = pack2(f0.z, f0.w); pk[2] = pack2(f1.x, f1.y); pk[3] = pack2(f1.z, f1.w);
          dst[512 + (a - 1) * 256 + tid] = pk;
        }
      }
      __syncthreads();
      if (tid == 0 && ((g & (NGRP - 1)) == NGRP - 2 + par || g + 2 >= 264)) {
        __builtin_amdgcn_fence(__ATOMIC_RELEASE, "agent");
        asm volatile("s_waitcnt vmcnt(0)" ::: "memory");
        st_flag(par ? f_prod1 : f_prod0, (unsigned)(g + 1));
      }
    }
    return;
  }
  {
    __builtin_amdgcn_s_setprio(3);
    bf16_t* Yd = (bf16_t*)(ws + (dir == 0 ? OFF_H : OFF_Y1));
    float S[8] = {0.f, 0.f, 0.f, 0.f, 0.f, 0.f, 0.f, 0.f};
    const int vrow = tid >> 3, kq = tid & 7;
    unsigned* f_me = vq ? f_cons1 : f_cons0;
    u32x4 rg[7];
    const u32x4* ringv = (const u32x4*)ring;
    wait_flags2(f_prod0, (unsigned)(NGRP - 1), f_prod1, (unsigned)NGRP);
    rg[0] = ringv[tid & 15];
#pragma unroll
    for (int q = 2; q < 7; ++q) rg[q] = ringv[q * 256 + tid];
    for (int g = 0; g < 264; ++g) {
      const int seg = g < 8 ? 0 : 1;
      const int ci = seg ? g - 8 : g;
      const int T = seg == 0 ? CTX : SEQ;
      const size_t rowbase = seg == 0 ? (size_t)(NL + b * CTX) : (size_t)b * SEQ;
      const bool with_out = seg == 1;
      const int nch = T / L;
      const int c0 = (dir == 0 ? ci : nch - 1 - ci) * L;
      (void)T; (void)rowbase; (void)nch; (void)c0;
      if (tid < 16) ((u32x4*)smem)[tid] = rg[0];
#pragma unroll
      for (int a = 1; a < 6; ++a) {
        const u32x4 v = rg[1 + a];
        u32x4 lo4, hi4;
        lo4[0] = v[0] << 16; lo4[1] = v[0] & 0xffff0000u; lo4[2] = v[1] << 16; lo4[3] = v[1] & 0xffff0000u;
        hi4[0] = v[2] << 16; hi4[1] = v[2] & 0xffff0000u; hi4[2] = v[3] << 16; hi4[3] = v[3] & 0xffff0000u;
        *(u32x4*)(smem + a * 8192 + tid * 32) = lo4;
        *(u32x4*)(smem + a * 8192 + tid * 32 + 16) = hi4;
      }
      __syncthreads();
      if (tid == 0) st_flag(f_me, (unsigned)(g + 1));
      if (g + 1 < 264) {
        if (((g + 1) & (NGRP - 1)) == 0) { const int G = min(g + 1 + NGRP, 264); wait_flags2(f_prod0, (unsigned)(G - 1), f_prod1, (unsigned)G); }
        const u32x4* srcn = ringv + ((g + 1) % NSLOT) * SLOT_U;
        rg[0] = srcn[tid & 15];
#pragma unroll
        for (int q = 2; q < 7; ++q) rg[q] = srcn[q * 256 + tid];
      }
      auto stepC = [&](auto wo_tag, auto dir_tag) {
        constexpr bool WO = decltype(wo_tag)::value;
        constexpr int DIR = decltype(dir_tag)::value;
        {
          float4 k4n[2], b4n[2], d4n[2], r4n[2];
          float vvn;
          auto ldtok = [&](int s) {
            const int tl = DIR == 0 ? s : L - 1 - s;
#pragma unroll
            for (int q = 0; q < 2; ++q) {
              k4n[q] = *(const float4*)(skk + tl * 64 + kq * 8 + q * 4);
              b4n[q] = *(const float4*)(sbb + tl * 64 + kq * 8 + q * 4);
              d4n[q] = *(const float4*)(skd + tl * 64 + kq * 8 + q * 4);
              r4n[q] = *(const float4*)(sr + tl * 64 + kq * 8 + q * 4);
            }
            vvn = sv[tl * 64 + vq * 32 + vrow];
          };
          ldtok(0);
          {
#pragma unroll
            for (int s = 0; s < L; ++s) {
              const int j8 = s & 7, s8 = s & ~7;
              float k8[8], b8[8], d8[8], r8[8];
#pragma unroll
              for (int q = 0; q < 2; ++q) {
                k8[4 * q] = k4n[q].x; k8[4 * q + 1] = k4n[q].y; k8[4 * q + 2] = k4n[q].z; k8[4 * q + 3] = k4n[q].w;
                b8[4 * q] = b4n[q].x; b8[4 * q + 1] = b4n[q].y; b8[4 * q + 2] = b4n[q].z; b8[4 * q + 3] = b4n[q].w;
                d8[4 * q] = d4n[q].x; d8[4 * q + 1] = d4n[q].y; d8[4 * q + 2] = d4n[q].z; d8[4 * q + 3] = d4n[q].w;
                r8[4 * q] = r4n[q].x; r8[4 * q + 1] = r4n[q].y; r8[4 * q + 2] = r4n[q].z; r8[4 * q + 3] = r4n[q].w;
              }
              const float vv = vvn;
              if (s + 1 < L) ldtok(s + 1);
              float sa0 = 0.f, sa1 = 0.f, pre[8];
#pragma unroll
              for (int i = 0; i < 8; i += 2) { sa0 += S[i] * k8[i]; sa1 += S[i + 1] * k8[i + 1]; }
#pragma unroll
              for (int i = 0; i < 8; ++i) pre[i] = S[i] + vv * d8[i];
              const float sa = red8(sa0 + sa1);
#pragma unroll
              for (int i = 0; i < 8; ++i) S[i] = pre[i] - sa * b8[i];
              if (WO) {
                float y0 = 0.f, y1 = 0.f;
#pragma unroll
                for (int i = 0; i < 8; i += 2) { y0 += S[i] * r8[i]; y1 += S[i + 1] * r8[i + 1]; }
                yp[j8 * 256 + tid] = y0 + y1;
              }
            if (WO && j8 == 7) {
              const int jt = lane >> 3, rw = lane & 7;
              const float4 p0 = *(const float4*)(yp + jt * 256 + wave * 64 + rw * 8);
              const float4 p1 = *(const float4*)(yp + jt * 256 + wave * 64 + rw * 8 + 4);
              const float y = ((p0.x + p0.y) + (p0.z + p0.w)) + ((p1.x + p1.y) + (p1.z + p1.w));
              const int sg = s8 + jt;
              const int tlg = DIR == 0 ? sg : L - 1 - sg;
              ys[tlg * 32 + wave * 8 + rw] = y;
            }
            }
          }
        }
        {
          const float4 e0 = *(const float4*)(sw_ + kq * 8), e1 = *(const float4*)(sw_ + kq * 8 + 4);
          S[0] *= e0.x; S[1] *= e0.y; S[2] *= e0.z; S[3] *= e0.w; S[4] *= e1.x; S[5] *= e1.y; S[6] *= e1.z; S[7] *= e1.w;
        }
      };
      if (dir == 0) { if (with_out) stepC(std::true_type{}, std::integral_constant<int, 0>{}); else stepC(std::false_type{}, std::integral_constant<int, 0>{}); }
      else { if (with_out) stepC(std::true_type{}, std::integral_constant<int, 1>{}); else stepC(std::false_type{}, std::integral_constant<int, 1>{}); }
        __syncthreads();
        if (with_out) {
          const int tok = tid >> 3, pr = (tid & 7) * 4;
          u32x2 o2;
          o2[0] = pack2(ys[tok * 32 + pr], ys[tok * 32 + pr + 1]);
          o2[1] = pack2(ys[tok * 32 + pr + 2], ys[tok * 32 + pr + 3]);
          *(u32x2*)(Yd + (rowbase + c0 + tok) * 1024 + h * 64 + vq * 32 + pr) = o2;
        }
    }
    __builtin_amdgcn_s_setprio(0);
  }
}

DI void phase_combine(const Params& p) {
  char* ws = p.ws;
  const int lane = get_tid() & 63, wave = get_tid() >> 6;
  bf16_t* Y0 = (bf16_t*)(ws + OFF_H);
  const bf16_t* Y1 = (const bf16_t*)(ws + OFF_Y1);
  const bf16_t* U1 = (const bf16_t*)(ws + OFF_U1);
  const float* bs0 = (const float*)(ws + OFF_BS);
  const float* bs1 = bs0 + (size_t)NL * 16;
  for (int it = blockIdx.x; it < NL / 2; it += gridDim.x) {
    const int row = it * 2 + (wave >> 1), hh = wave & 1;
    const int t = row & 8191;
    const int ch0 = hh * 512 + lane * 8;
    const int head = ch0 >> 6;
    u32x4 a4 = *(const u32x4*)(Y0 + (size_t)row * 1024 + ch0);
    u32x4 b4 = *(const u32x4*)(Y1 + (size_t)row * 1024 + ch0);
    float y[8];
#pragma unroll
    for (int e = 0; e < 4; ++e) { y[2 * e] = lo2f(a4[e]) + lo2f(b4[e]); y[2 * e + 1] = hi2f(a4[e]) + hi2f(b4[e]); }
    float s = 0.f;
#pragma unroll
    for (int e = 0; e < 8; ++e) s += y[e];
    s += __shfl_xor(s, 1); s += __shfl_xor(s, 2); s += __shfl_xor(s, 4);
    const float mu = s * (1.f / 64.f);
    float vs = 0.f;
#pragma unroll
    for (int e = 0; e < 8; ++e) { float dd = y[e] - mu; vs += dd * dd; }
    vs += __shfl_xor(vs, 1); vs += __shfl_xor(vs, 2); vs += __shfl_xor(vs, 4);
    const float rstd = rsqrtf(vs * (1.f / 64.f) + 64e-5f);
    const float bsum = bs0[(size_t)row * 16 + head] + bs1[(size_t)row * 16 + head];
    const bf16_t* uv = U1 + (size_t)row * 4352 + 1024 + ch0;
    u32x4 vc = *(const u32x4*)uv;
    u32x4 vp = {0, 0, 0, 0}, vn = {0, 0, 0, 0};
    if (t > 0) vp = *(const u32x4*)(uv - 4352);
    if (t < SEQ - 1) vn = *(const u32x4*)(uv + 4352);
    u32x4 g4 = *(const u32x4*)(U1 + (size_t)row * 4352 + 3328 + ch0);
    float o[8];
#pragma unroll
    for (int e = 0; e < 8; ++e) {
      const int cc = ch0 + e;
      const unsigned pv = vp[e >> 1], cv = vc[e >> 1], nv = vn[e >> 1], gv = g4[e >> 1];
      const float fp = (e & 1) ? hi2f(pv) : lo2f(pv), fc = (e & 1) ? hi2f(cv) : lo2f(cv), fn = (e & 1) ? hi2f(nv) : lo2f(nv);
      const float vsh = p.o_shift_w[1024 + cc] * fp + p.o_shift_w[3328 + 1024 + cc] * fc + p.o_shift_w[2 * 3328 + 1024 + cc] * fn;
      const float gg = (e & 1) ? hi2f(gv) : lo2f(gv);
      o[e] = ((y[e] - mu) * rstd * p.o_gn_w[cc] + p.o_gn_b[cc] + bsum * vsh) * gg;
    }
    u32x4 pk;
    pk[0] = pack2(o[0], o[1]); pk[1] = pack2(o[2], o[3]); pk[2] = pack2(o[4], o[5]); pk[3] = pack2(o[6], o[7]);
    *(u32x4*)(Y0 + (size_t)row * 1024 + ch0) = pk;
  }
}

template <int PH>
DI void run_phase(const Params& p, char* smem) {
  if (PH == 0) phase_prep1(p, smem);
  else if (PH == 1) phase_prep2(p, smem);
  else if (PH == 2) phase_inproj_e(p, smem);
  else if (PH == 3) phase_up(p, smem);
  else if (PH == 4) phase_attn(p, smem);
  else if (PH == 5) phase_outproj(p, smem, 0);
  else if (PH == 6) norm_rows(p.out, (const float*)(p.ws + OFF_CTX1), p.norm_g + 1024, (const float*)(p.ws + OFF_MOD) + 5 * 3072, (bf16_t*)(p.ws + OFF_H));
  else if (PH == 7) phase_inproj_o(p, smem);
  else if (PH == 8) phase_scan(p, smem);
  else if (PH == 9) phase_combine(p);
  else if (PH == 10) phase_outproj(p, smem, 1);
}

extern "C" __global__ void __launch_bounds__(256, 2) mega_kernel(Params p) {
  extern __shared__ __attribute__((aligned(16))) char smem[];
  cg::grid_group grid = cg::this_grid();
  run_phase<0>(p, smem); grid.sync();
#ifdef REP0
  run_phase<0>(p, smem); grid.sync();
#endif
  run_phase<1>(p, smem); grid.sync();
#ifdef REP1
  run_phase<1>(p, smem); grid.sync();
#endif
  run_phase<2>(p, smem); grid.sync();
#ifdef REP2
  run_phase<2>(p, smem); grid.sync();
#endif
  run_phase<3>(p, smem); grid.sync();
#ifdef REP3
  run_phase<3>(p, smem); grid.sync();
#endif
  run_phase<4>(p, smem); grid.sync();
#ifdef REP4
  run_phase<4>(p, smem); grid.sync();
#endif
  run_phase<5>(p, smem); grid.sync();
  run_phase<7>(p, smem); grid.sync();
#ifdef REP7
  run_phase<7>(p, smem); grid.sync();
#endif
  run_phase<8>(p, smem); grid.sync();
#ifdef REP8
  run_phase<8>(p, smem); grid.sync();
#endif
  run_phase<9>(p, smem); grid.sync();
  run_phase<10>(p, smem);
}

template <int PH>
__global__ void __launch_bounds__(256, 2) phase_kernel(Params p) {
  extern __shared__ __attribute__((aligned(16))) char smem[];
  run_phase<PH>(p, smem);
}

template <int PH>
static void launch_phase(const Params& p, int grid, hipStream_t stream) {
  hipFuncSetAttribute((const void*)phase_kernel<PH>, hipFuncAttributeMaxDynamicSharedMemorySize, SMEM_BYTES);
  hipLaunchKernelGGL(phase_kernel<PH>, dim3(grid), dim3(256), SMEM_BYTES, stream, p);
}

extern "C" void kernel_launch(void* const* d_in, const int* in_sizes, int n_in, void* d_out, int out_size, void* d_ws,
                              size_t ws_size, hipStream_t stream) {
  Params p{};
  const float** pp = (const float**)&p;
  for (int i = 0; i < 28; ++i) pp[i] = (const float*)d_in[i];
  p.out = (float*)d_out;
  p.ws = (char*)d_ws;
#if N_LAUNCH_MODE == 1
  static int grid_blocks = 0;
  if (!grid_blocks) {
    int dev = 0, cus = 0, per_cu = 0;
    hipGetDevice(&dev);
    hipDeviceGetAttribute(&cus, hipDeviceAttributeMultiprocessorCount, dev);
    hipFuncSetAttribute((const void*)mega_kernel, hipFuncAttributeMaxDynamicSharedMemorySize, SMEM_BYTES);
    hipOccupancyMaxActiveBlocksPerMultiprocessor(&per_cu, (const void*)mega_kernel, 256, SMEM_BYTES);
    if (per_cu < 1) per_cu = 1;
    if (per_cu > 2) per_cu = 2;
    grid_blocks = cus * per_cu;
  }
  (void)hipMemsetAsync((char*)d_ws + OFF_FLG, 0, 32768, stream);
  void* args[] = {&p};
  hipError_t e = hipLaunchCooperativeKernel((const void*)mega_kernel, dim3(grid_blocks), dim3(256), args, SMEM_BYTES, stream);
  if (e != hipSuccess) fprintf(stderr, "cooperative launch failed: %s (grid %d)\n", hipGetErrorString(e), grid_blocks);
#else
  const int grid = 512;
  launch_phase<0>(p, grid, stream); launch_phase<1>(p, grid, stream); launch_phase<2>(p, grid, stream);
  launch_phase<3>(p, grid, stream); launch_phase<4>(p, grid, stream); launch_phase<5>(p, grid, stream);
  launch_phase<6>(p, grid, stream); launch_phase<7>(p, grid, stream); launch_phase<8>(p, grid, stream);
  launch_phase<9>(p, grid, stream); launch_phase<10>(p, grid, stream);
#endif
}
```

```cpp
#include <hip/hip_runtime.h>
#include <hip/hip_cooperative_groups.h>
#include <stdint.h>
#include <type_traits>
#include <stdio.h>
namespace cg = cooperative_groups;

#define DI __device__ __forceinline__
typedef unsigned short bf16_t;
typedef __attribute__((ext_vector_type(8))) short bf16x8;
typedef __attribute__((ext_vector_type(16))) float f32x16;
typedef __attribute__((ext_vector_type(4))) unsigned int u32x4;
typedef __attribute__((ext_vector_type(2))) unsigned int u32x2;

#ifndef N_LAUNCH_MODE
#define N_LAUNCH_MODE 1
#endif

DI int get_tid() { int t = threadIdx.x; asm volatile("" : "+v"(t)); return t; }
DI bf16_t f2bf(float x) { unsigned u = __float_as_uint(x); u += 0x7fffu + ((u >> 16) & 1u); return (bf16_t)(u >> 16); }
DI float bf2f(bf16_t b) { return __uint_as_float(((unsigned)b) << 16); }
typedef __bf16 bf2_t __attribute__((ext_vector_type(2)));
typedef float f2_t __attribute__((ext_vector_type(2)));
DI unsigned pack2(float a, float b) { f2_t v = {a, b}; return __builtin_bit_cast(unsigned, __builtin_convertvector(v, bf2_t)); }
DI float lo2f(unsigned u) { return __uint_as_float(u << 16); }
DI float hi2f(unsigned u) { return __uint_as_float(u & 0xffff0000u); }
DI float siluf(float x) { return x / (1.f + __expf(-x)); }
DI float sigm(float x) { return __builtin_amdgcn_rcpf(1.f + __expf(-x)); }

constexpr int D = 1024, NB = 4, SEQ = 8192, CTX = 256;
constexpr int NL = NB * SEQ, NC = NB * CTX, NR = NL + NC;
constexpr int KEYS = SEQ + CTX;
constexpr float EPS = 1e-6f;
constexpr float QSCALE = 0.10206207261596577f * 1.4426950408889634f;

constexpr size_t OFF_WINE = 0;
constexpr size_t OFF_WUKV = OFF_WINE + 2816ull * 1024 * 2;
constexpr size_t OFF_WUQ = OFF_WUKV + 1024ull * 256 * 2;
constexpr size_t OFF_WOUTE = OFF_WUQ + 1024ull * 384 * 2;
constexpr size_t OFF_WINO = OFF_WOUTE + 1024ull * 1024 * 2;
constexpr size_t OFF_WOUTO = OFF_WINO + 4352ull * 1024 * 2;
constexpr size_t OFF_DFT128 = OFF_WOUTO + 1024ull * 1024 * 2;
constexpr size_t OFF_DFT64 = OFF_DFT128 + 256 * 256 * 2;
constexpr size_t OFF_DFTC = OFF_DFT64 + 128 * 128 * 2;
constexpr size_t OFF_MAB = OFF_DFTC + 256 * 512 * 2;
constexpr size_t OFF_MOD = OFF_MAB + 8 * 128 * 128 * 4;
constexpr size_t OFF_CTX1 = OFF_MOD + 2 * 5 * 3072 * 4;
constexpr size_t OFF_TW = OFF_CTX1 + 1024ull * 1024 * 4;
constexpr size_t OFF_BIG = 32ull << 20;
constexpr size_t OFF_FLG = OFF_BIG - 65536;
constexpr size_t OFF_SSQ = OFF_TW + 65536;
constexpr size_t OFF_BIAS1 = OFF_SSQ + (size_t)NR * 8 * 4;
static_assert(OFF_BIAS1 + 5 * 4352 * 4 <= OFF_FLG, "small region overflow");
constexpr size_t OFF_H = OFF_BIG;
constexpr size_t OFF_UKVQ = OFF_H + (size_t)NR * 1024 * 2;
constexpr size_t OFF_ZT = OFF_UKVQ + (size_t)NR * 768 * 2;
constexpr size_t OFF_ZC = OFF_ZT + 4ull * 512 * 64 * 256 * 2;
constexpr size_t OFF_YT = OFF_ZC + 4ull * 512 * 512 * 2;
constexpr size_t OFF_G0 = OFF_YT + 4ull * 128 * 512 * 128 * 2;
constexpr size_t OFF_Q = OFF_G0 + (size_t)NR * 1024 * 2;
constexpr size_t OFF_K = OFF_Q + 4ull * 8 * KEYS * 96 * 2;
constexpr size_t OFF_VT = OFF_K + 4ull * 8 * KEYS * 96 * 2;
constexpr size_t END0 = OFF_VT + 4ull * 8 * 64 * KEYS * 2;
constexpr size_t OFF_U1 = OFF_UKVQ;
constexpr size_t OFF_Y1 = OFF_U1 + (size_t)NR * 4352 * 2;
constexpr size_t OFF_BS = OFF_Y1 + (size_t)NL * 1024 * 2;
constexpr size_t OFF_RING = OFF_BS + 2ull * NL * 16 * 4;
constexpr size_t OFF_A1 = OFF_Y1;
static_assert(OFF_A1 + (size_t)NR * 1024 * 2 <= OFF_RING, "A1 overlaps the ring");
constexpr size_t END1 = OFF_RING + 128ull * 16 * 28672;
static_assert(END0 <= (512ull << 20) && END1 <= (512ull << 20), "workspace overflow");

struct Params {
  const float *x, *c, *ctx, *c_ctx, *ada_w, *ada_b, *norm_g, *e_w_in, *e_kv_norm, *e_q_norm, *e_w_uq, *e_w_ukv,
      *e_q_head_norm, *e_k_head_norm, *e_w_fnet, *e_w_out, *o_w_in, *o_shift_w, *o_w0, *o_w2, *o_a0, *o_a2, *o_k_k,
      *o_k_a, *o_r_k, *o_gn_w, *o_gn_b, *o_w_out;
  float* out;
  char* ws;
};

constexpr int BK = 64, LDS_LD = 72;
constexpr int OPER_ELEMS = 128 * LDS_LD;
constexpr int CLD = 129;
constexpr int SMEM_MAIN = 4 * OPER_ELEMS * 2;
constexpr int SMEM_BYTES = SMEM_MAIN + 1024;

template <class ARowF, class BRowF>
DI void gemm_mainloop(ARowF arow, BRowF brow, int K, char* smem, f32x16 (&acc)[2][2]) {
  const int tid = get_tid(), lane = tid & 63, wave = tid >> 6;
  const int wm = wave >> 1, wn = wave & 1;
  const int lr = tid >> 3, lc = (tid & 7) * 8;
  const bf16_t* ap[4];
  const bf16_t* bp[4];
#pragma unroll
  for (int i = 0; i < 4; ++i) { ap[i] = arow(lr + 32 * i) + lc; bp[i] = brow(lr + 32 * i) + lc; }
  const int KT = K / BK;
  u32x4 ra[2][4], rb[2][4];
#pragma unroll
  for (int i = 0; i < 4; ++i) { ra[0][i] = *(const u32x4*)(ap[i]); rb[0][i] = *(const u32x4*)(bp[i]); }
  if (KT > 1) {
#pragma unroll
    for (int i = 0; i < 4; ++i) { ra[1][i] = *(const u32x4*)(ap[i] + BK); rb[1][i] = *(const u32x4*)(bp[i] + BK); }
  }
  bf16_t* S = (bf16_t*)smem;
#pragma unroll
  for (int i = 0; i < 4; ++i) {
    *(u32x4*)(S + (lr + 32 * i) * LDS_LD + lc) = ra[0][i];
    *(u32x4*)(S + OPER_ELEMS + (lr + 32 * i) * LDS_LD + lc) = rb[0][i];
  }
  __syncthreads();
  const int arow_off = (wm * 64 + (lane & 31)) * LDS_LD + (lane >> 5) * 8;
  const int brow_off = (wn * 64 + (lane & 31)) * LDS_LD + (lane >> 5) * 8;
  auto step = [&](int kt, u32x4 (&rna)[4], u32x4 (&rnb)[4], u32x4 (&rfa)[4], u32x4 (&rfb)[4]) {
    const bf16_t* Ac = S + (kt & 1) * 2 * OPER_ELEMS;
    const bf16_t* Bc = Ac + OPER_ELEMS;
    if (kt + 2 < KT) {
#pragma unroll
      for (int i = 0; i < 4; ++i) {
        rfa[i] = *(const u32x4*)(ap[i] + (kt + 2) * BK);
        rfb[i] = *(const u32x4*)(bp[i] + (kt + 2) * BK);
      }
    }
    __builtin_amdgcn_sched_barrier(0);
#pragma unroll
    for (int ks = 0; ks < 4; ++ks) {
      bf16x8 a0 = *(const bf16x8*)(Ac + arow_off + ks * 16);
      bf16x8 a1 = *(const bf16x8*)(Ac + arow_off + 32 * LDS_LD + ks * 16);
      bf16x8 b0 = *(const bf16x8*)(Bc + brow_off + ks * 16);
      bf16x8 b1 = *(const bf16x8*)(Bc + brow_off + 32 * LDS_LD + ks * 16);
      acc[0][0] = __builtin_amdgcn_mfma_f32_32x32x16_bf16(a0, b0, acc[0][0], 0, 0, 0);
      acc[0][1] = __builtin_amdgcn_mfma_f32_32x32x16_bf16(a0, b1, acc[0][1], 0, 0, 0);
      acc[1][0] = __builtin_amdgcn_mfma_f32_32x32x16_bf16(a1, b0, acc[1][0], 0, 0, 0);
      acc[1][1] = __builtin_amdgcn_mfma_f32_32x32x16_bf16(a1, b1, acc[1][1], 0, 0, 0);
    }
    if (kt + 1 < KT) {
      bf16_t* An = S + ((kt + 1) & 1) * 2 * OPER_ELEMS;
#pragma unroll
      for (int i = 0; i < 4; ++i) {
        *(u32x4*)(An + (lr + 32 * i) * LDS_LD + lc) = rna[i];
        *(u32x4*)(An + OPER_ELEMS + (lr + 32 * i) * LDS_LD + lc) = rnb[i];
      }
    }
    __syncthreads();
  };
  for (int kt = 0; kt < KT; kt += 2) {
    step(kt, ra[1], rb[1], ra[0], rb[0]);
    if (kt + 1 < KT) step(kt + 1, ra[0], rb[0], ra[1], rb[1]);
  }
}

template <class ARowF, class BRowF, class EpiF>
DI void gemm_tile(ARowF arow, BRowF brow, int K, char* smem, EpiF epi) {
  f32x16 acc[2][2];
#pragma unroll
  for (int i = 0; i < 2; ++i)
#pragma unroll
    for (int j = 0; j < 2; ++j)
#pragma unroll
      for (int r = 0; r < 16; ++r) acc[i][j][r] = 0.f;
  gemm_mainloop(arow, brow, K, smem, acc);
  float* Cs = (float*)smem;
  const int lane = get_tid() & 63, wave = get_tid() >> 6;
  const int wm = wave >> 1, wn = wave & 1;
#pragma unroll
  for (int i = 0; i < 2; ++i)
#pragma unroll
    for (int j = 0; j < 2; ++j)
#pragma unroll
      for (int r = 0; r < 16; ++r) {
        int row = wm * 64 + i * 32 + (r & 3) + 8 * (r >> 2) + 4 * (lane >> 5);
        int col = wn * 64 + j * 32 + (lane & 31);
        Cs[row * CLD + col] = acc[i][j][r];
      }
  __syncthreads();
  epi(Cs);
  __syncthreads();
}

template <class RowPtrF>
DI void store_tile_bf16(const float* Cs, RowPtrF rowptr, bool do_silu) {
  const int tid = get_tid();
#pragma unroll
  for (int q = 0; q < 8; ++q) {
    const int c = tid + 256 * q;
    const int i = c >> 4, ch = c & 15;
    float v[8];
#pragma unroll
    for (int e = 0; e < 8; ++e) { v[e] = Cs[i * CLD + ch * 8 + e]; if (do_silu) v[e] = siluf(v[e]); }
    u32x4 pk;
    pk[0] = pack2(v[0], v[1]); pk[1] = pack2(v[2], v[3]); pk[2] = pack2(v[4], v[5]); pk[3] = pack2(v[6], v[7]);
    *(u32x4*)(rowptr(i) + ch * 8) = pk;
  }
}

DI void store_row64(const float* crow, bf16_t* dst, bool do_silu) {
#pragma unroll
  for (int q = 0; q < 8; ++q) {
    float v[8];
#pragma unroll
    for (int e = 0; e < 8; ++e) { v[e] = crow[q * 8 + e]; if (do_silu) v[e] = siluf(v[e]); }
    u32x4 pk;
    pk[0] = pack2(v[0], v[1]); pk[1] = pack2(v[2], v[3]); pk[2] = pack2(v[4], v[5]); pk[3] = pack2(v[6], v[7]);
    *(u32x4*)(dst + q * 8) = pk;
  }
}

template <class F>
DI void tile_walk(int NG, int NNT, F f) {
  if ((gridDim.x & 7) == 0) {
    const int xcd = blockIdx.x & 7, j = blockIdx.x >> 3, nper = gridDim.x >> 3;
    const int len = (NG >> 3) * NNT * 8;
    for (int t = j; t < len; t += nper) {
      const int gl = t / (NNT * 8), rem = t - gl * (NNT * 8);
      f((gl * 8 + xcd) * 8 + (rem & 7), rem >> 3);
    }
  } else {
    for (int t = blockIdx.x; t < NG * 8 * NNT; t += gridDim.x) f(t / NNT, t % NNT);
  }
}

DI int srccol(int mapid, int n) {
  if (mapid == 0) return n;
  if (mapid == 1) return n < 256 ? n : (n < 640 ? n + 32 : (n < 672 ? n - 640 + 256 : -1));
  if (mapid == 2) return 1184 + n;
  return (n & 127) < 96 ? (n >> 7) * 96 + (n & 127) : -1;
}

DI void transpose_item(const float* src, int lds, bf16_t* dst, int ldd, int mapid, const float* scale, int kt, int ntile,
                       char* smem) {
  float* t = (float*)smem;
  const int tid = get_tid();
  const int k0 = kt * 64, n0 = ntile * 64;
  {
    const int n = tid & 63;
    const int sc = srccol(mapid, n0 + n);
#pragma unroll 4
    for (int p = 0; p < 16; ++p) {
      int k = p * 4 + (tid >> 6);
      float v = 0.f;
      if (sc >= 0) { v = src[(size_t)(k0 + k) * lds + sc]; if (scale) v *= scale[k0 + k]; }
      t[k * 65 + n] = v;
    }
  }
  __syncthreads();
  {
    const int n = tid >> 2, kq = (tid & 3) * 16;
    u32x4 p0, p1;
    float v[16];
#pragma unroll
    for (int i = 0; i < 16; ++i) v[i] = t[(kq + i) * 65 + n];
    p0[0] = pack2(v[0], v[1]); p0[1] = pack2(v[2], v[3]); p0[2] = pack2(v[4], v[5]); p0[3] = pack2(v[6], v[7]);
    p1[0] = pack2(v[8], v[9]); p1[1] = pack2(v[10], v[11]); p1[2] = pack2(v[12], v[13]); p1[3] = pack2(v[14], v[15]);
    bf16_t* d = dst + (size_t)(n0 + n) * ldd + k0 + kq;
    *(u32x4*)d = p0;
    *(u32x4*)(d + 8) = p1;
  }
  __syncthreads();
}

DI void phase_prep1(const Params& p, char* smem) {
  const int tid = get_tid();
  char* ws = p.ws;
  if (blockIdx.x == 0) {
    for (int i = tid; i < 8192; i += 256) ((unsigned*)(ws + OFF_FLG))[i] = 0u;
  }
  constexpr int N_MOD = 384;
  constexpr int T0 = 16 * 12;
  constexpr int T1 = 16 * 16;
  constexpr int T2 = 6 * 16;
  constexpr int T3 = 4 * 16;
  constexpr int T4 = 16 * 16;
  constexpr int T5 = 16 * 68;
  constexpr int T6 = 16 * 16;
  constexpr int N_TR = T0 + T1 + T2 + T3 + T4 + T5 + T6;
  constexpr int N_TAB = 256 + 64 + 512 + 32;
  constexpr int N_MAB = 512;
  constexpr int TOTAL = N_MOD + N_TR + N_TAB + N_MAB;
  for (int it = blockIdx.x; it < TOTAL; it += gridDim.x) {
    if (it < N_MOD) {
      const int l = it / 192, chunk = it % 192;
      float* scond = (float*)smem;
      float* red = scond + 5120;
      for (int idx = tid; idx < 5120; idx += 256) {
        int j = idx >> 10, k = idx & 1023;
        float cv = j < 4 ? p.c[j * 1024 + k] : p.c_ctx[k];
        scond[idx] = siluf(cv);
      }
      __syncthreads();
      const int kg = tid >> 4, cl = tid & 15;
      const int n = chunk * 16 + cl;
      float a[5] = {0.f, 0.f, 0.f, 0.f, 0.f};
      const float* w = p.ada_w + (size_t)l * 1024 * 3072 + n;
#pragma unroll 16
      for (int k = kg * 64; k < kg * 64 + 64; ++k) {
        float wv = w[(size_t)k * 3072];
#pragma unroll
        for (int j = 0; j < 5; ++j) a[j] += scond[j * 1024 + k] * wv;
      }
#pragma unroll
      for (int j = 0; j < 5; ++j) red[tid * 5 + j] = a[j];
      __syncthreads();
      if (tid < 80) {
        int j = tid >> 4, c2 = tid & 15;
        float s = 0.f;
        for (int g = 0; g < 16; ++g) s += red[(g * 16 + c2) * 5 + j];
        int nn = chunk * 16 + c2;
        ((float*)(ws + OFF_MOD))[(l * 5 + j) * 3072 + nn] = s + p.ada_b[l * 3072 + nn];
      }
      __syncthreads();
      continue;
    }
    int r = it - N_MOD;
    if (r < N_TR) {
      if (r < T0) { transpose_item(p.e_w_in, 2208, (bf16_t*)(ws + OFF_WINE), 1024, 1, nullptr, r % 16, r / 16, smem); continue; }
      r -= T0;
      if (r < T1) { transpose_item(p.e_w_in, 2208, (bf16_t*)(ws + OFF_WINE) + 1792ull * 1024, 1024, 2, nullptr, r % 16, r / 16, smem); continue; }
      r -= T1;
      if (r < T2) { transpose_item(p.e_w_uq, 768, (bf16_t*)(ws + OFF_WUQ), 384, 3, p.e_q_norm, r % 6, r / 6, smem); continue; }
      r -= T2;
      if (r < T3) { transpose_item(p.e_w_ukv, 1024, (bf16_t*)(ws + OFF_WUKV), 256, 0, p.e_kv_norm, r % 4, r / 4, smem); continue; }
      r -= T3;
      if (r < T4) { transpose_item(p.e_w_out, 1024, (bf16_t*)(ws + OFF_WOUTE), 1024, 0, nullptr, r % 16, r / 16, smem); continue; }
      r -= T4;
      if (r < T5) { transpose_item(p.o_w_in, 4352, (bf16_t*)(ws + OFF_WINO), 1024, 0, nullptr, r % 16, r / 16, smem); continue; }
      r -= T5;
      transpose_item(p.o_w_out, 1024, (bf16_t*)(ws + OFF_WOUTO), 1024, 0, nullptr, r % 16, r / 16, smem);
      continue;
    }
    r -= N_TR;
    if (r < N_TAB) {
      if (r < 256) {
        int idx = r * 256 + tid;
        int m = idx >> 8, kk = idx & 255;
        int k2 = m >> 1, ro = m & 1, ri = kk >> 7, n2 = kk & 127;
        float s, c;
        sincospif((float)((n2 * k2) & 127) * (1.f / 64.f), &s, &c);
        float v = (ro == 0) ? (ri == 0 ? c : s) : (ri == 0 ? -s : c);
        ((bf16_t*)(ws + OFF_DFT128))[idx] = f2bf(v);
      } else if (r < 320) {
        int idx = (r - 256) * 256 + tid;
        int k1 = idx >> 7, kk = idx & 127;
        int ro = kk >> 6, n1 = kk & 63;
        float v = 0.f;
        if (k1 < 64) {
          float s, c;
          sincospif((float)((n1 * k1) & 63) * (1.f / 32.f), &s, &c);
          v = (ro == 0 ? c : s) * 0.011048543456039806f;
        }
        ((bf16_t*)(ws + OFF_DFT64))[idx] = f2bf(v);
      } else if (r >= 832) {
        int idx = (r - 832) * 256 + tid;
        int k2 = idx >> 6, n1 = idx & 63;
        float sn, cs;
        sincospif((float)((n1 * k2) & 8191) * (1.f / 4096.f), &sn, &cs);
        ((float2*)(ws + OFF_TW))[idx] = make_float2(cs, sn);
      } else {
        int idx = (r - 320) * 256 + tid;
        int k = idx >> 9, kk = idx & 511;
        int ri = kk >> 8, t = kk & 255;
        float s, c;
        sincospif((float)((k * t) & 255) * (1.f / 128.f), &s, &c);
        ((bf16_t*)(ws + OFF_DFTC))[idx] = f2bf((ri == 0 ? c : s) * 0.0625f);
      }
      continue;
    }
    r -= N_TAB;
    {
      float* tc = (float*)smem;
      if (tid < 128) {
        float s, c;
        sincospif((float)tid * (1.f / 64.f), &s, &c);
        tc[tid] = c; tc[128 + tid] = s;
      }
      __syncthreads();
      const int gt = r >> 6, sub = r & 63;
      const int g = gt >> 1, type = gt & 1;
      const int c = sub * 2 + (tid >> 7), d = tid & 127;
      const float* wf = p.e_w_fnet + (size_t)g * 128 * 128 + d;
      float acc = 0.f;
#pragma unroll 8
      for (int cp = 0; cp < 128; ++cp) acc += tc[type * 128 + ((c * cp) & 127)] * wf[cp * 128];
      const float sc = type ? -0.08838834764831845f : 0.08838834764831845f;
      ((float*)(ws + OFF_MAB))[((size_t)gt * 128 + c) * 128 + d] = acc * sc;
      __syncthreads();
    }
  }
}

DI void norm_rows(const float* xl, const float* xc, const float* g, const float* mod  , bf16_t* hb) {
  const int lane = get_tid() & 63, wave = get_tid() >> 6;
  for (int it = blockIdx.x; it < NR / 4; it += gridDim.x) {
    const int row = it * 4 + wave;
    const float* src;
    int j;
    if (row < NL) { src = xl + (size_t)row * 1024; j = row >> 13; } else { src = xc + (size_t)(row - NL) * 1024; j = 4; }
    float4 v[4];
    float ss = 0.f;
#pragma unroll
    for (int q = 0; q < 4; ++q) {
      v[q] = *(const float4*)(src + q * 256 + lane * 4);
      ss += v[q].x * v[q].x + v[q].y * v[q].y + v[q].z * v[q].z + v[q].w * v[q].w;
    }
#pragma unroll
    for (int o = 32; o >= 1; o >>= 1) ss += __shfl_xor(ss, o);
    const float rs = rsqrtf(ss * (1.f / 1024.f) + EPS);
    const float* sh = mod + j * 3072;
    const float* sc = sh + 1024;
#pragma unroll
    for (int q = 0; q < 4; ++q) {
      const int cidx = q * 256 + lane * 4;
      float4 gg = *(const float4*)(g + cidx);
      float4 s1 = *(const float4*)(sc + cidx);
      float4 s0 = *(const float4*)(sh + cidx);
      float o0 = v[q].x * rs * gg.x * (1.f + s1.x) + s0.x;
      float o1 = v[q].y * rs * gg.y * (1.f + s1.y) + s0.y;
      float o2 = v[q].z * rs * gg.z * (1.f + s1.z) + s0.z;
      float o3 = v[q].w * rs * gg.w * (1.f + s1.w) + s0.w;
      u32x2 pk; pk[0] = pack2(o0, o1); pk[1] = pack2(o2, o3);
      *(u32x2*)(hb + (size_t)row * 1024 + cidx) = pk;
    }
  }
}

DI void phase_prep2(const Params& p, char* smem) {
  const int tid = get_tid();
  char* ws = p.ws;
  for (int it = blockIdx.x; it < 512; it += gridDim.x) {
    const int gt = it >> 6, ch = it & 63;
    const int g = gt >> 1, type = gt & 1;
    float* mab = (float*)smem;
    float* wl = mab + 128 * 128;
    const float* msrc = (const float*)(ws + OFF_MAB) + (size_t)gt * 16384;
    for (int i = tid; i < 16384; i += 256) mab[i] = msrc[i];
    for (int i = tid; i < 2048; i += 256) {
      int kd = i >> 7, c = i & 127;
      wl[i] = p.e_w_in[(size_t)(ch * 16 + kd) * 2208 + 672 + g * 128 + c];
    }
    __syncthreads();
    const int d = tid & 127, half = tid >> 7;
    float acc[8] = {0.f, 0.f, 0.f, 0.f, 0.f, 0.f, 0.f, 0.f};
    for (int c = 0; c < 128; ++c) {
      float m = mab[c * 128 + d];
#pragma unroll
      for (int q = 0; q < 8; ++q) acc[q] += wl[(half * 8 + q) * 128 + c] * m;
    }
    u32x4 pk;
    pk[0] = pack2(acc[0], acc[1]); pk[1] = pack2(acc[2], acc[3]); pk[2] = pack2(acc[4], acc[5]); pk[3] = pack2(acc[6], acc[7]);
    bf16_t* dst = (bf16_t*)(ws + OFF_WINE) + (size_t)(768 + type * 512 + g * 128 + d) * 1024 + ch * 16 + half * 8;
    *(u32x4*)dst = pk;
    __syncthreads();
  }
  {
    const int lane = tid & 63, wave = tid >> 6;
    const float* mod1 = (const float*)(ws + OFF_MOD) + 5 * 3072;
    const bf16_t* Wt = (const bf16_t*)(ws + OFF_WINO);
    for (int it = blockIdx.x; it < 4352 / 4; it += gridDim.x) {
      const int n = it * 4 + wave;
      const u32x4 w0 = *(const u32x4*)(Wt + (size_t)n * 1024 + lane * 16);
      const u32x4 w1 = *(const u32x4*)(Wt + (size_t)n * 1024 + lane * 16 + 8);
      float wv[16];
#pragma unroll
      for (int e = 0; e < 4; ++e) { wv[2 * e] = lo2f(w0[e]); wv[2 * e + 1] = hi2f(w0[e]); wv[8 + 2 * e] = lo2f(w1[e]); wv[8 + 2 * e + 1] = hi2f(w1[e]); }
#pragma unroll
      for (int j = 0; j < 5; ++j) {
        const float* sh = mod1 + j * 3072 + lane * 16;
        float a = 0.f;
#pragma unroll
        for (int q = 0; q < 4; ++q) {
          const float4 s4 = *(const float4*)(sh + q * 4);
          a += s4.x * wv[4 * q] + s4.y * wv[4 * q + 1] + s4.z * wv[4 * q + 2] + s4.w * wv[4 * q + 3];
        }
#pragma unroll
        for (int o = 32; o >= 1; o >>= 1) a += __shfl_xor(a, o);
        if (lane == 0) ((float*)(ws + OFF_BIAS1))[j * 4352 + n] = a;
      }
    }
  }
  norm_rows(p.x, p.ctx, p.norm_g, (const float*)(ws + OFF_MOD), (bf16_t*)(ws + OFF_H));
}

DI int tokrow_e(int mt, int i) { return mt < 256 ? ((mt >> 6) * 8192 + (mt & 63) + 64 * i) : (NL + (mt - 256) * 128 + i); }

DI void phase_inproj_e(const Params& p, char* smem) {
  char* ws = p.ws;
  const int tid = get_tid();
  const bf16_t* hb = (const bf16_t*)(ws + OFF_H);
  const bf16_t* W = (const bf16_t*)(ws + OFF_WINE);
  auto do_tile = [&](int mt, int nt) {
    auto arow = [&](int i) { return hb + (size_t)tokrow_e(mt, i) * 1024; };
    auto brow = [&](int i) { return W + (size_t)(nt * 128 + i) * 1024; };
    gemm_tile(arow, brow, 1024, smem, [&](const float* Cs) {
      if (nt < 6 || nt >= 14) {
        store_tile_bf16(Cs, [&](int i) {
          const int row = tokrow_e(mt, i);
          return (nt < 6) ? (bf16_t*)(ws + OFF_UKVQ) + (size_t)row * 768 + nt * 128
                          : (bf16_t*)(ws + OFF_G0) + (size_t)row * 1024 + (nt - 14) * 128;
        }, nt >= 14);
      } else {
        const int ri = (nt - 6) >> 2, jb = (nt - 6) & 3;
#pragma unroll
        for (int q = 0; q < 8; ++q) {
          const int cc = tid + 256 * q;
          const int c = cc >> 4, ch = cc & 15;
          const int j = jb * 128 + c;
          bf16_t* dst;
          if (mt < 256) {
            const int b = mt >> 6, n1 = mt & 63;
            dst = (bf16_t*)(ws + OFF_ZT) + ((((size_t)b * 512 + j) * 64 + n1) * 2 + ri) * 128 + ch * 8;
          } else {
            const int b = (mt - 256) >> 1, hf = (mt - 256) & 1;
            dst = (bf16_t*)(ws + OFF_ZC) + (((size_t)b * 512 + j) * 2 + ri) * 256 + hf * 128 + ch * 8;
          }
          float v[8];
#pragma unroll
          for (int e = 0; e < 8; ++e) v[e] = Cs[(ch * 8 + e) * CLD + c];
          u32x4 pk;
          pk[0] = pack2(v[0], v[1]); pk[1] = pack2(v[2], v[3]); pk[2] = pack2(v[4], v[5]); pk[3] = pack2(v[6], v[7]);
          *(u32x4*)dst = pk;
        }
      }
    });
  };
  tile_walk(32, 22, do_tile);
  for (int it = blockIdx.x; it < 8 * 22; it += gridDim.x) do_tile(256 + it / 22, it % 22);
}

DI void head_finish(float (&k)[48], int hf, const float* normw, bool lat, int pos, float scale, bf16_t* dst) {
  asm volatile("" : "+s"(normw));
  float ss = 0.f;
#pragma unroll
  for (int e = 0; e < 48; ++e) ss += k[e] * k[e];
  ss += __shfl_xor(ss, 1);
  const float rn = rsqrtf(ss * (1.f / 96.f) + EPS);
#pragma unroll
  for (int e = 0; e < 48; ++e) k[e] = k[e] * rn * normw[hf * 48 + e];
  if (lat && hf == 1) {
    const float inv[8] = {1.f, 0.31622776601683794f, 0.1f, 0.031622776601683794f, 0.01f, 0.0031622776601683794f, 0.001f, 0.00031622776601683794f};
    const float pr = (float)(pos >> 6), pc = (float)(pos & 63);
#pragma unroll
    for (int a = 0; a < 2; ++a)
#pragma unroll
      for (int f = 0; f < 8; ++f) {
        const float ang = (a == 0 ? pr : pc) * inv[f];
        const float sn = __sinf(ang), cs = __cosf(ang);
        const float x1 = k[16 + 16 * a + f], x2 = k[16 + 16 * a + 8 + f];
        k[16 + 16 * a + f] = x1 * cs - x2 * sn;
        k[16 + 16 * a + 8 + f] = x2 * cs + x1 * sn;
      }
  }
#pragma unroll
  for (int q = 0; q < 6; ++q) {
    u32x4 pk;
    pk[0] = pack2(k[q * 8 + 0] * scale, k[q * 8 + 1] * scale); pk[1] = pack2(k[q * 8 + 2] * scale, k[q * 8 + 3] * scale);
    pk[2] = pack2(k[q * 8 + 4] * scale, k[q * 8 + 5] * scale); pk[3] = pack2(k[q * 8 + 6] * scale, k[q * 8 + 7] * scale);
    *(u32x4*)(dst + hf * 48 + q * 8) = pk;
  }
}

DI void row_stats(const bf16_t* base, int ld, int col0, int ncols, float* rstat) {
  const int tid = get_tid(), i = tid >> 1, hf = tid & 1;
  const int half = ncols >> 1;
  const bf16_t* src = base + (size_t)i * ld + col0 + hf * half;
  float ss = 0.f;
  for (int q = 0; q < half / 8; ++q) {
    u32x4 v = *(const u32x4*)(src + q * 8);
#pragma unroll
    for (int e = 0; e < 4; ++e) { float a = lo2f(v[e]), b = hi2f(v[e]); ss += a * a + b * b; }
  }
  ss += __shfl_xor(ss, 1);
  if (hf == 0) rstat[i] = rsqrtf(ss / (float)ncols + EPS);
}

DI void phase_up(const Params& p, char* smem) {
  char* ws = p.ws;
  const int tid = get_tid();
  float* rstat = (float*)(smem + SMEM_MAIN);
  const bf16_t* U = (const bf16_t*)(ws + OFF_UKVQ);
  constexpr int N_KV = 264 * 8, N_Q = 264 * 8, N_F1 = 2048, N_CD = 32;
  auto do_up = [&](int mt, int hq) {
    {
      const bool isq = hq >= 8;
      const int h = hq & 7;
      const int row0 = mt * 128;
      const bool lat = row0 < NL;
      const int b = lat ? (row0 >> 13) : ((row0 - NL) >> 8);
      const int pos0 = lat ? (row0 & 8191) : (8192 + ((row0 - NL) & 255));
      row_stats(U + (size_t)row0 * 768, 768, isq ? 256 : 0, isq ? 384 : 256, rstat);
      if (!isq) {
        const bf16_t* W = (const bf16_t*)(ws + OFF_WUKV);
        auto arow = [&](int i) { return U + (size_t)(row0 + i) * 768; };
        auto brow = [&](int i) { return W + (size_t)(h * 128 + i) * 256; };
        gemm_tile(arow, brow, 256, smem, [&](const float* Cs) {
          {
            const int i = tid >> 1, hf = tid & 1;
            const float rr = rstat[i];
            float k[48];
            if (hf == 0) {
#pragma unroll
              for (int e = 0; e < 48; ++e) k[e] = Cs[i * CLD + e] * rr;
            } else {
#pragma unroll
              for (int e = 0; e < 16; ++e) k[e] = Cs[i * CLD + 48 + e] * rr;
              const bf16_t* pe = U + (size_t)(row0 + i) * 768 + 640;
#pragma unroll
              for (int q = 0; q < 4; ++q) {
                u32x4 v = *(const u32x4*)(pe + q * 8);
#pragma unroll
                for (int e = 0; e < 4; ++e) { k[16 + q * 8 + 2 * e] = lo2f(v[e]); k[16 + q * 8 + 2 * e + 1] = hi2f(v[e]); }
              }
            }
            head_finish(k, hf, p.e_k_head_norm, lat, pos0 + i, 1.f, (bf16_t*)(ws + OFF_K) + ((size_t)(b * 8 + h) * KEYS + pos0 + i) * 96);
          }
#pragma unroll
          for (int q = 0; q < 4; ++q) {
            const int cc = tid + 256 * q;
            const int d = cc >> 4, ch = cc & 15;
            bf16_t* dst = (bf16_t*)(ws + OFF_VT) + ((size_t)(b * 8 + h) * 64 + d) * KEYS + pos0 + ch * 8;
            float v[8];
#pragma unroll
            for (int e = 0; e < 8; ++e) { const int i = ch * 8 + e; v[e] = Cs[i * CLD + 64 + d] * rstat[i]; }
            u32x4 pk;
            pk[0] = pack2(v[0], v[1]); pk[1] = pack2(v[2], v[3]); pk[2] = pack2(v[4], v[5]); pk[3] = pack2(v[6], v[7]);
            *(u32x4*)dst = pk;
          }
        });
      } else {
        const bf16_t* W = (const bf16_t*)(ws + OFF_WUQ);
        auto arow = [&](int i) { return U + (size_t)(row0 + i) * 768 + 256; };
        auto brow = [&](int i) { return W + (size_t)(h * 128 + i) * 384; };
        gemm_tile(arow, brow, 384, smem, [&](const float* Cs) {
          {
            const int i = tid >> 1, hf = tid & 1;
            const float rr = rstat[i];
            float k[48];
#pragma unroll
            for (int e = 0; e < 48; ++e) k[e] = Cs[i * CLD + hf * 48 + e] * rr;
            head_finish(k, hf, p.e_q_head_norm, lat, pos0 + i, QSCALE, (bf16_t*)(ws + OFF_Q) + ((size_t)(b * 8 + h) * KEYS + pos0 + i) * 96);
          }
        });
      }
    }
  };
  tile_walk(32, 16, do_up);
  for (int it = blockIdx.x; it < 128 + N_F1 + N_CD; it += gridDim.x) {
    if (it < 128) { do_up(256 + (it >> 4), it & 15); continue; }
    int r = it - 128;
    if (r < N_F1) {
      const int half = r & 1, jp = (r >> 1) & 255, b = r >> 9;
      const bf16_t* A = (const bf16_t*)(ws + OFF_DFT128) + (size_t)half * 128 * 256;
      const bf16_t* Bt = (const bf16_t*)(ws + OFF_ZT) + ((size_t)b * 512 + jp * 2) * 64 * 256;
      auto arow = [&](int i) { return A + (size_t)i * 256; };
      auto brow = [&](int i) { return Bt + (size_t)i * 256; };
      gemm_tile(arow, brow, 256, smem, [&](const float* Cs) {
        const int n = tid & 127, mh = tid >> 7;
        const int jj = n >> 6, n1 = n & 63;
        const int j = jp * 2 + jj;
        bf16_t* Y = (bf16_t*)(ws + OFF_YT);
#pragma unroll 2
        for (int q = 0; q < 32; ++q) {
          const int k2l = mh * 32 + q;
          const int k2 = half * 64 + k2l;
          const float yr = Cs[(2 * k2l) * CLD + n], yi = Cs[(2 * k2l + 1) * CLD + n];
          const float2 tw = ((const float2*)(ws + OFF_TW))[k2 * 64 + n1];
          const float c = tw.x, s = tw.y;
          const float o_r = yr * c + yi * s, o_i = yi * c - yr * s;
          bf16_t* dst = Y + ((((size_t)b * 128 + k2) * 512 + j) * 2) * 64 + n1;
          dst[0] = f2bf(o_r);
          dst[64] = f2bf(o_i);
        }
      });
      continue;
    }
    r -= N_F1;
    {
      const int nt4 = r & 3, mt2 = (r >> 2) & 1, b = r >> 3;
      const bf16_t* A = (const bf16_t*)(ws + OFF_DFTC) + (size_t)mt2 * 128 * 512;
      const bf16_t* Bt = (const bf16_t*)(ws + OFF_ZC) + ((size_t)b * 512 + nt4 * 128) * 512;
      auto arow = [&](int i) { return A + (size_t)i * 512; };
      auto brow = [&](int i) { return Bt + (size_t)i * 512; };
      gemm_tile(arow, brow, 512, smem, [&](const float* Cs) {
        const int i = tid >> 1, chh = tid & 1;
        const size_t off = (size_t)(NL + b * 256 + mt2 * 128 + i) * 1024 + 512 + nt4 * 128 + chh * 64;
        const bf16_t* gs = (const bf16_t*)(ws + OFF_G0) + off;
        bf16_t* dst = (bf16_t*)(ws + OFF_H) + off;
#pragma unroll
        for (int q = 0; q < 8; ++q) {
          u32x4 g4 = *(const u32x4*)(gs + q * 8);
          u32x4 pk;
#pragma unroll
          for (int e = 0; e < 4; ++e) {
            float v0 = Cs[i * CLD + chh * 64 + q * 8 + 2 * e] * lo2f(g4[e]);
            float v1 = Cs[i * CLD + chh * 64 + q * 8 + 2 * e + 1] * hi2f(g4[e]);
            pk[e] = pack2(v0, v1);
          }
          *(u32x4*)(dst + q * 8) = pk;
        }
      });
    }
  }
}

DI void attn_simple(const Params& p, char* smem, int b, int h, int q0, int key0, int nkeys) {
  char* ws = p.ws;
  const int tid = get_tid();
  float* Ks = (float*)smem;
  float* Vs = Ks + 32 * 96;
  const bf16_t* Qp = (const bf16_t*)(ws + OFF_Q) + ((size_t)(b * 8 + h) * KEYS + q0 + tid) * 96;
  const bf16_t* Kp = (const bf16_t*)(ws + OFF_K) + (size_t)(b * 8 + h) * KEYS * 96;
  const bf16_t* Vp = (const bf16_t*)(ws + OFF_VT) + (size_t)(b * 8 + h) * 64 * KEYS;
  float q[96];
#pragma unroll
  for (int qq = 0; qq < 12; ++qq) {
    u32x4 v = *(const u32x4*)(Qp + qq * 8);
#pragma unroll
    for (int e = 0; e < 4; ++e) { q[qq * 8 + 2 * e] = lo2f(v[e]); q[qq * 8 + 2 * e + 1] = hi2f(v[e]); }
  }
  float acc[64];
#pragma unroll
  for (int d = 0; d < 64; ++d) acc[d] = 0.f;
  float m = -1e30f, l = 0.f;
  for (int kt = 0; kt < nkeys; kt += 32) {
    __syncthreads();
    for (int idx = tid; idx < 32 * 96 / 2; idx += 256) {
      unsigned v = *(const unsigned*)(Kp + (size_t)(key0 + kt) * 96 + idx * 2);
      Ks[idx * 2] = lo2f(v); Ks[idx * 2 + 1] = hi2f(v);
    }
    for (int idx = tid; idx < 32 * 64; idx += 256) {
      int d = idx >> 5, kk = idx & 31;
      Vs[kk * 64 + d] = bf2f(Vp[(size_t)d * KEYS + key0 + kt + kk]);
    }
    __syncthreads();
    for (int kk = 0; kk < 32; ++kk) {
      const float4* kr = (const float4*)(Ks + kk * 96);
      float s = 0.f;
#pragma unroll
      for (int e = 0; e < 24; ++e) {
        float4 kv = kr[e];
        s += q[4 * e] * kv.x + q[4 * e + 1] * kv.y + q[4 * e + 2] * kv.z + q[4 * e + 3] * kv.w;
      }
      if (s > m) {
        const float corr = exp2f(m - s);
        l *= corr;
#pragma unroll
        for (int d = 0; d < 64; ++d) acc[d] *= corr;
        m = s;
      }
      const float pw = exp2f(s - m);
      l += pw;
      const float4* vr = (const float4*)(Vs + kk * 64);
#pragma unroll
      for (int e = 0; e < 16; ++e) {
        float4 vv = vr[e];
        acc[4 * e] += pw * vv.x; acc[4 * e + 1] += pw * vv.y; acc[4 * e + 2] += pw * vv.z; acc[4 * e + 3] += pw * vv.w;
      }
    }
  }
  const float il = 1.f / l;
  const int row = (q0 < SEQ) ? (b * 8192 + q0 + tid) : (NL + b * 256 + (q0 - SEQ) + tid);
  const size_t off = (size_t)row * 1024 + h * 64;
  const bf16_t* gs = (const bf16_t*)(ws + OFF_G0) + off;
  bf16_t* dst = (bf16_t*)(ws + OFF_H) + off;
#pragma unroll
  for (int qq = 0; qq < 8; ++qq) {
    u32x4 g4 = *(const u32x4*)(gs + qq * 8);
    u32x4 pk;
#pragma unroll
    for (int e = 0; e < 4; ++e) pk[e] = pack2(acc[qq * 8 + 2 * e] * il * lo2f(g4[e]), acc[qq * 8 + 2 * e + 1] * il * hi2f(g4[e]));
    *(u32x4*)(dst + qq * 8) = pk;
  }
  __syncthreads();
}

constexpr int AK_LD = 104, AV_LD = 72;
constexpr int AK_ELEMS = 64 * AK_LD, AV_ELEMS = 64 * AV_LD, ASTAGE = AK_ELEMS + AV_ELEMS;

DI void attn_mfma(const Params& p, char* smem, int b, int h, int q0, int key0, int nkeys, float negc) {
  char* ws = p.ws;
  const int tid = get_tid(), lane = tid & 63, wave = tid >> 6;
  const int r = lane & 31, hh = lane >> 5;
  const size_t bh = (size_t)(b * 8 + h);
  const bf16_t* Qp = (const bf16_t*)(ws + OFF_Q) + (bh * KEYS + q0 + wave * 64 + r) * 96 + hh * 8;
  bf16x8 qf[2][6];
#pragma unroll
  for (int t = 0; t < 2; ++t)
#pragma unroll
    for (int s = 0; s < 6; ++s) qf[t][s] = *(const bf16x8*)(Qp + t * 32 * 96 + 16 * s);
  const bf16_t* Kg = (const bf16_t*)(ws + OFF_K) + (bh * KEYS + key0) * 96;
  const bf16_t* Vg = (const bf16_t*)(ws + OFF_VT) + bh * 64 * KEYS + key0;
  bf16_t* S0 = (bf16_t*)smem;
  u32x4 rk[3], rv[2];
  int kdst[3], vdst[2];
  unsigned vsrc[2];
#pragma unroll
  for (int i = 0; i < 3; ++i) { int c = tid + 256 * i; kdst[i] = (c / 12) * AK_LD + (c % 12) * 8; }
#pragma unroll
  for (int i = 0; i < 2; ++i) { int c = tid + 256 * i; vdst[i] = AK_ELEMS + (c >> 3) * AV_LD + (c & 7) * 8; vsrc[i] = (unsigned)((c >> 3) * KEYS + (c & 7) * 8); }
#pragma unroll
  for (int i = 0; i < 3; ++i) rk[i] = *(const u32x4*)(Kg + (tid + 256 * i) * 8);
#pragma unroll
  for (int i = 0; i < 2; ++i) rv[i] = *(const u32x4*)(Vg + vsrc[i]);
#pragma unroll
  for (int i = 0; i < 3; ++i) *(u32x4*)(S0 + kdst[i]) = rk[i];
#pragma unroll
  for (int i = 0; i < 2; ++i) *(u32x4*)(S0 + vdst[i]) = rv[i];
  __syncthreads();
  f32x16 O[2][2];
#pragma unroll
  for (int t = 0; t < 2; ++t)
#pragma unroll
    for (int i = 0; i < 16; ++i) { O[t][0][i] = 0.f; O[t][1][i] = 0.f; }
  float lsum[2] = {0.f, 0.f};
  const int NT = nkeys >> 6;
  for (int kt = 0; kt < NT; ++kt) {
    const bf16_t* Ks = S0 + (kt & 1) * ASTAGE;
    const bf16_t* Vs = Ks + AK_ELEMS;
    if (kt + 1 < NT) {
#pragma unroll
      for (int i = 0; i < 3; ++i) rk[i] = *(const u32x4*)(Kg + (size_t)(kt + 1) * 6144 + (tid + 256 * i) * 8);
#pragma unroll
      for (int i = 0; i < 2; ++i) rv[i] = *(const u32x4*)(Vg + vsrc[i] + (kt + 1) * 64);
    }
#pragma unroll 1
    for (int sub = 0; sub < 2; ++sub) {
      f32x16 S[2];
#pragma unroll
      for (int i = 0; i < 16; ++i) { S[0][i] = negc; S[1][i] = negc; }
#pragma unroll
      for (int s = 0; s < 6; ++s) {
        const bf16x8 a = *(const bf16x8*)(Ks + (sub * 32 + r) * AK_LD + 16 * s + 8 * hh);
        S[0] = __builtin_amdgcn_mfma_f32_32x32x16_bf16(a, qf[0][s], S[0], 0, 0, 0);
        S[1] = __builtin_amdgcn_mfma_f32_32x32x16_bf16(a, qf[1][s], S[1], 0, 0, 0);
      }
      bf16x8 pb[2][2];
#pragma unroll
      for (int t = 0; t < 2; ++t) {
        float pv[16];
#pragma unroll
        for (int i = 0; i < 16; ++i) { pv[i] = __builtin_amdgcn_exp2f(S[t][i]); lsum[t] += pv[i]; }
#pragma unroll
        for (int s2 = 0; s2 < 2; ++s2) {
          u32x4 pk;
          pk[0] = pack2(pv[8 * s2 + 0], pv[8 * s2 + 1]); pk[1] = pack2(pv[8 * s2 + 2], pv[8 * s2 + 3]);
          pk[2] = pack2(pv[8 * s2 + 4], pv[8 * s2 + 5]); pk[3] = pack2(pv[8 * s2 + 6], pv[8 * s2 + 7]);
          pb[t][s2] = __builtin_bit_cast(bf16x8, pk);
        }
      }
#pragma unroll
      for (int s2 = 0; s2 < 2; ++s2)
#pragma unroll
        for (int dt = 0; dt < 2; ++dt) {
          const bf16_t* vp = Vs + (dt * 32 + r) * AV_LD + sub * 32 + 16 * s2 + 4 * hh;
          u32x2 lo = *(const u32x2*)vp;
          u32x2 hi = *(const u32x2*)(vp + 8);
          u32x4 va4; va4[0] = lo[0]; va4[1] = lo[1]; va4[2] = hi[0]; va4[3] = hi[1];
          const bf16x8 va = __builtin_bit_cast(bf16x8, va4);
          O[0][dt] = __builtin_amdgcn_mfma_f32_32x32x16_bf16(va, pb[0][s2], O[0][dt], 0, 0, 0);
          O[1][dt] = __builtin_amdgcn_mfma_f32_32x32x16_bf16(va, pb[1][s2], O[1][dt], 0, 0, 0);
        }
    }
    if (kt + 1 < NT) {
      bf16_t* Sn = S0 + ((kt + 1) & 1) * ASTAGE;
#pragma unroll
      for (int i = 0; i < 3; ++i) *(u32x4*)(Sn + kdst[i]) = rk[i];
#pragma unroll
      for (int i = 0; i < 2; ++i) *(u32x4*)(Sn + vdst[i]) = rv[i];
    }
    __syncthreads();
  }
#pragma unroll
  for (int t = 0; t < 2; ++t) {
    const float ltot = lsum[t] + __shfl_xor(lsum[t], 32);
    const float il = 1.f / ltot;
    const int pos = q0 + wave * 64 + t * 32 + r;
    const int row = (q0 < SEQ) ? (b * 8192 + pos) : (NL + b * 256 + pos - SEQ);
    const size_t off = (size_t)row * 1024 + h * 64;
    const bf16_t* gs = (const bf16_t*)(ws + OFF_G0) + off;
    bf16_t* dst = (bf16_t*)(ws + OFF_H) + off;
#pragma unroll
    for (int dt = 0; dt < 2; ++dt)
#pragma unroll
      for (int g = 0; g < 4; ++g) {
        const int d0 = dt * 32 + 8 * g + 4 * hh;
        u32x2 g2 = *(const u32x2*)(gs + d0);
        u32x2 o2;
        o2[0] = pack2(O[t][dt][4 * g] * il * lo2f(g2[0]), O[t][dt][4 * g + 1] * il * hi2f(g2[0]));
        o2[1] = pack2(O[t][dt][4 * g + 2] * il * lo2f(g2[1]), O[t][dt][4 * g + 3] * il * hi2f(g2[1]));
        *(u32x2*)(dst + d0) = o2;
      }
  }
}

DI void phase_attn(const Params& p, char* smem) {
  char* ws = p.ws;
  const int tid = get_tid();
  float negc;
  {
    float mq = 0.f, mk = 0.f;
    for (int e = 0; e < 96; ++e) { mq = fmaxf(mq, fabsf(p.e_q_head_norm[e])); mk = fmaxf(mk, fabsf(p.e_k_head_norm[e])); }
    negc = -(9.797958971132712f * 1.4426950408889634f) * mq * mk;
  }
  {
    const int xcd = blockIdx.x & 7, j = blockIdx.x >> 3, nper = gridDim.x >> 3;
    if (nper > 0 && (gridDim.x & 7) == 0) {
      for (int li = j; li < 128; li += nper) {
        const int pair = (li >> 5) * 8 + xcd, qb = li & 31;
        attn_mfma(p, smem, pair >> 3, pair & 7, qb * 256, 0, KEYS, negc);
      }
    } else {
      for (int it = blockIdx.x; it < 1024; it += gridDim.x) attn_mfma(p, smem, it >> 8, (it >> 5) & 7, (it & 31) * 256, 0, KEYS, negc);
    }
  }
  constexpr int N_AL = 0, N_AC = 32, N_F2 = 2048;
  for (int it = blockIdx.x; it < N_AL + N_AC + N_F2; it += gridDim.x) {
    if (it < N_AL + N_AC) {
      const int r = it - N_AL;
      attn_mfma(p, smem, r >> 3, r & 7, SEQ, SEQ, CTX, negc);
      continue;
    }
    {
      const int r = it - N_AL - N_AC;
      const int jb = r & 3, k2 = (r >> 2) & 127, b = r >> 9;
      const bf16_t* A = (const bf16_t*)(ws + OFF_YT) + (((size_t)b * 128 + k2) * 512 + jb * 128) * 128;
      const bf16_t* Bt = (const bf16_t*)(ws + OFF_DFT64);
      auto arow = [&](int i) { return A + (size_t)i * 128; };
      auto brow = [&](int i) { return Bt + (size_t)i * 128; };
      gemm_tile(arow, brow, 128, smem, [&](const float* Cs) {
#pragma unroll
        for (int q = 0; q < 4; ++q) {
          const int cc = tid + 256 * q;
          const int n = cc >> 4, ch = cc & 15;
          const size_t off = (size_t)(b * 8192 + 128 * n + k2) * 1024 + 512 + jb * 128 + ch * 8;
          const u32x4 g4 = *(const u32x4*)((const bf16_t*)(ws + OFF_G0) + off);
          u32x4 pk;
#pragma unroll
          for (int e = 0; e < 4; ++e) {
            const float v0 = Cs[(ch * 8 + 2 * e) * CLD + n] * lo2f(g4[e]);
            const float v1 = Cs[(ch * 8 + 2 * e + 1) * CLD + n] * hi2f(g4[e]);
            pk[e] = pack2(v0, v1);
          }
          *(u32x4*)((bf16_t*)(ws + OFF_H) + off) = pk;
        }
      });
    }
  }
}

template <int CTRL>
DI float dpp_xadd(float x) {
  int t = __builtin_amdgcn_update_dpp(0, __builtin_bit_cast(int, x), CTRL, 0xF, 0xF, true);
  return x + __builtin_bit_cast(float, t);
}
DI void phase_outproj(const Params& p, char* smem, int layer) {
  char* ws = p.ws;
  const int tid = get_tid();
  const bf16_t* A = (const bf16_t*)(ws + OFF_H);
  const bf16_t* W = (const bf16_t*)(ws + (layer == 0 ? OFF_WOUTE : OFF_WOUTO));
  const float* mod = (const float*)(ws + OFF_MOD) + layer * 5 * 3072;
  const int nmt = layer == 0 ? 264 : 256;
  auto do_tile = [&](int mt, int nt) {
    auto arow = [&](int i) { return A + (size_t)(mt * 128 + i) * 1024; };
    auto brow = [&](int i) { return W + (size_t)(nt * 128 + i) * 1024; };
    gemm_tile(arow, brow, 1024, smem, [&](const float* Cs) {
      const int c4 = (tid & 31) * 4, r0 = tid >> 5;
      const int n = nt * 128 + c4;
      const int row0 = mt * 128;
      const bool lat = row0 < NL;
      const float4 gm = *(const float4*)(mod + (lat ? (row0 >> 13) : 4) * 3072 + 2048 + n);
      const float* xin = lat ? ((layer == 0 ? p.x : p.out) + (size_t)row0 * 1024 + n) : (p.ctx + (size_t)(row0 - NL) * 1024 + n);
      float* xo = lat ? (p.out + (size_t)row0 * 1024 + n) : ((float*)(ws + OFF_CTX1) + (size_t)(row0 - NL) * 1024 + n);
      float4 gs = make_float4(0.f, 0.f, 0.f, 0.f);
      if (layer == 0) {
        const float4 g1 = *(const float4*)(p.norm_g + 1024 + n);
        const float4 s1 = *(const float4*)(mod + 5 * 3072 + (lat ? (row0 >> 13) : 4) * 3072 + 1024 + n);
        gs = make_float4(g1.x * (1.f + s1.x), g1.y * (1.f + s1.y), g1.z * (1.f + s1.z), g1.w * (1.f + s1.w));
      }
#pragma unroll 4
      for (int q = 0; q < 16; ++q) {
        const int i = r0 + 8 * q;
        float4 xv = *(const float4*)(xin + (size_t)i * 1024);
        xv.x += gm.x * Cs[i * CLD + c4]; xv.y += gm.y * Cs[i * CLD + c4 + 1];
        xv.z += gm.z * Cs[i * CLD + c4 + 2]; xv.w += gm.w * Cs[i * CLD + c4 + 3];
        *(float4*)(xo + (size_t)i * 1024) = xv;
        if (layer == 0) {
          u32x2 a2;
          a2[0] = pack2(xv.x * gs.x, xv.y * gs.y); a2[1] = pack2(xv.z * gs.z, xv.w * gs.w);
          *(u32x2*)((bf16_t*)(ws + OFF_A1) + (size_t)(row0 + i) * 1024 + n) = a2;
          float ss = xv.x * xv.x + xv.y * xv.y + xv.z * xv.z + xv.w * xv.w;
          ss = dpp_xadd<0xB1>(ss); ss = dpp_xadd<0x4E>(ss); ss = dpp_xadd<0x141>(ss); ss = dpp_xadd<0x140>(ss);
          ss += __shfl_xor(ss, 16);
          if ((tid & 31) == 0) ((float*)(ws + OFF_SSQ))[(size_t)(row0 + i) * 8 + nt] = ss;
        }
      }
    });
  };
  tile_walk(32, 8, do_tile);
  for (int it = blockIdx.x; it < (nmt - 256) * 8; it += gridDim.x) do_tile(256 + (it >> 3), it & 7);
}

DI void phase_inproj_o(const Params& p, char* smem) {
  char* ws = p.ws;
  const int tid = get_tid();
  const bf16_t* hb = (const bf16_t*)(ws + OFF_A1);
  const bf16_t* W = (const bf16_t*)(ws + OFF_WINO);
  bf16_t* U1 = (bf16_t*)(ws + OFF_U1);
  float* rstat = (float*)(smem + SMEM_MAIN);
  auto do_tile = [&](int mt, int nt) {
    if (tid < 128) {
      const float4* sp = (const float4*)((const float*)(ws + OFF_SSQ) + (size_t)(mt * 128 + tid) * 8);
      const float4 s0 = sp[0], s1 = sp[1];
      const float ss = ((s0.x + s0.y) + (s0.z + s0.w)) + ((s1.x + s1.y) + (s1.z + s1.w));
      rstat[tid] = rsqrtf(ss * (1.f / 1024.f) + EPS);
    }
    const float* bias = (const float*)(ws + OFF_BIAS1) + (mt < 256 ? (mt >> 6) : 4) * 4352 + nt * 128;
    auto arow = [&](int i) { return hb + (size_t)(mt * 128 + i) * 1024; };
    auto brow = [&](int i) { return W + (size_t)(nt * 128 + i) * 1024; };
    gemm_tile(arow, brow, 1024, smem, [&](const float* Cs) {
      const bool do_silu = nt >= 26;
#pragma unroll
      for (int q = 0; q < 8; ++q) {
        const int c = tid + 256 * q;
        const int i = c >> 4, ch = c & 15;
        const float rs = rstat[i];
        const float4 b0 = *(const float4*)(bias + ch * 8), b1 = *(const float4*)(bias + ch * 8 + 4);
        const float bb[8] = {b0.x, b0.y, b0.z, b0.w, b1.x, b1.y, b1.z, b1.w};
        float v[8];
#pragma unroll
        for (int e = 0; e < 8; ++e) { v[e] = Cs[i * CLD + ch * 8 + e] * rs + bb[e]; if (do_silu) v[e] = siluf(v[e]); }
        u32x4 pk;
        pk[0] = pack2(v[0], v[1]); pk[1] = pack2(v[2], v[3]); pk[2] = pack2(v[4], v[5]); pk[3] = pack2(v[6], v[7]);
        *(u32x4*)(U1 + (size_t)(mt * 128 + i) * 4352 + nt * 128 + ch * 8) = pk;
      }
    });
  };
  tile_walk(32, 34, do_tile);
  for (int it = blockIdx.x; it < 8 * 18; it += gridDim.x) do_tile(256 + it / 18, it % 18);
}

DI float red8(float x) { x = dpp_xadd<0xB1>(x); x = dpp_xadd<0x4E>(x); x = dpp_xadd<0x141>(x); return x; }
DI float red16(float x) { x = red8(x); x = dpp_xadd<0x140>(x); return x; }
DI float fast_tanh(float x) { float e = __expf(2.f * x); return 1.f - 2.f * __builtin_amdgcn_rcpf(1.f + e); }

DI void phase_scan_fallback(const Params& p, char* smem) {
  char* ws = p.ws;
  const int tid = get_tid(), lane = tid & 63, wave = tid >> 6;
  const int r31 = lane & 31, hh = lane >> 5;
  const bf16_t* U1 = (const bf16_t*)(ws + OFF_U1);
  constexpr int L = 32;
  float* sw_ = (float*)smem;
  float* skk = sw_ + L * 64;
  float* sbb = skk + L * 64;
  float* skd = sbb + L * 64;
  float* sr = skd + L * 64;
  float* sv = sr + L * 64;
  bf16_t* t1b = (bf16_t*)(sv + L * 64);
  bf16_t* t2b = t1b + L * 72;
  float* invn = (float*)(t2b + L * 72);
  float* ys = invn + L;
  float* yp = ys + L * 32;
  const bool std_grid = gridDim.x == 512;
  for (int it0 = blockIdx.x; it0 < (std_grid ? 512 : 256); it0 += gridDim.x) {
    int it = it0;
    if (std_grid) {
      const int xcd = it0 & 7, j = it0 >> 3;
      if ((j & 1) != (j >> 5)) continue;
      const int idx = (j < 32) ? (j >> 1) : (16 + ((j - 32) >> 1));
      it = (((idx >> 2) * 8 + xcd) << 2) | (idx & 3);
    }
    const int vq = it & 1, dir = (it >> 1) & 1, h = (it >> 2) & 15, b = it >> 6;
    bf16_t* Yd = (bf16_t*)(ws + (dir == 0 ? OFF_H : OFF_Y1));
    float* bsd = (float*)(ws + OFF_BS) + (size_t)dir * NL * 16;
    float S[8] = {0.f, 0.f, 0.f, 0.f, 0.f, 0.f, 0.f, 0.f};
    const int c = tid & 63, tg = tid >> 6;
    const int hc = h * 64 + c;
    const float w0c = p.o_w0[dir * 1024 + hc], a0c = p.o_a0[dir * 1024 + hc];
    const float kkc = p.o_k_k[hc], kac = p.o_k_a[hc];
    const int cols[5] = {hc, 1024 + hc, 2304 + hc, 2048 + dir * 64 + c, 2176 + dir * 64 + c};
    float swc[5][3];
#pragma unroll
    for (int a = 0; a < 5; ++a)
#pragma unroll
      for (int j = 0; j < 3; ++j) swc[a][j] = p.o_shift_w[j * 3328 + cols[a]];
    const int mat = wave >> 1, nt = wave & 1;
    bf16x8 bfr[4];
    {
      const float* lw = (mat == 0 ? p.o_w2 : p.o_a2) + (size_t)dir * 64 * 1024 + h * 64 + nt * 32 + r31;
#pragma unroll
      for (int s = 0; s < 4; ++s) {
        u32x4 pk;
#pragma unroll
        for (int e = 0; e < 4; ++e) {
          const int k0 = 16 * s + 8 * hh + 2 * e;
          pk[e] = pack2(lw[(size_t)k0 * 1024], lw[(size_t)(k0 + 1) * 1024]);
        }
        bfr[s] = __builtin_bit_cast(bf16x8, pk);
      }
    }
    const int rt = tid >> 3, part = tid & 7;
    float kk8[8], rk8[8];
#pragma unroll
    for (int e = 0; e < 8; ++e) { kk8[e] = p.o_k_k[h * 64 + part * 8 + e]; rk8[e] = p.o_r_k[h * 64 + part * 8 + e]; }
    const int vrow = tid >> 3, kq = tid & 7;
    float u[5][10];
    unsigned raw[5][10];
    auto issue_chunk = [&](int g) {
      const int seg = g < 8 ? 0 : 1;
      const int ci = seg ? g - 8 : g;
      const int T = seg == 0 ? CTX : SEQ;
      const int nch = T / L;
      const size_t rowbase = seg == 0 ? (size_t)(NL + b * CTX) : (size_t)b * SEQ;
      const int c0 = (dir == 0 ? ci : nch - 1 - ci) * L;
#pragma unroll
      for (int a = 0; a < 5; ++a) {
        const bf16_t* up = U1 + rowbase * 4352 + cols[a] - ((a == 2 && seg == 0) ? 1024 : 0);
#pragma unroll
        for (int q = 0; q < 10; ++q) {
          const int t = c0 + tg * 8 - 1 + q;
          const int tc = min(max(t, 0), T - 1);
          raw[a][q] = up[(size_t)tc * 4352];
        }
      }
    };
    auto finish_chunk = [&](int g) {
      const int seg = g < 8 ? 0 : 1;
      const int ci = seg ? g - 8 : g;
      const int T = seg == 0 ? CTX : SEQ;
      const int nch = T / L;
      const int c0 = (dir == 0 ? ci : nch - 1 - ci) * L;
#pragma unroll
      for (int a = 0; a < 5; ++a)
        asm volatile("" : "+v"(raw[a][0]), "+v"(raw[a][1]), "+v"(raw[a][2]), "+v"(raw[a][3]), "+v"(raw[a][4]), "+v"(raw[a][5]),
                     "+v"(raw[a][6]), "+v"(raw[a][7]), "+v"(raw[a][8]), "+v"(raw[a][9]));
#pragma unroll
      for (int a = 0; a < 5; ++a)
#pragma unroll
        for (int q = 0; q < 10; ++q) {
          const int t = c0 + tg * 8 - 1 + q;
          const bool ok = (t >= 0) && (t < T) && !(a == 2 && seg == 0);
          u[a][q] = ok ? __uint_as_float(raw[a][q] << 16) : 0.f;
        }
    };
    issue_chunk(0);
    for (int g = 0; g < 264; ++g) {
      {
        const int seg = g < 8 ? 0 : 1;
        const int ci = seg ? g - 8 : g;
        const int T = seg == 0 ? CTX : SEQ;
        const size_t rowbase = seg == 0 ? (size_t)(NL + b * CTX) : (size_t)b * SEQ;
        const bool with_out = seg == 1;
        const int nch = T / L;
        const int c0 = (dir == 0 ? ci : nch - 1 - ci) * L;
        finish_chunk(g);
#pragma unroll
        for (int a = 0; a < 5; ++a) {
#pragma unroll
          for (int tt = 0; tt < 8; ++tt) {
            const float z = swc[a][0] * u[a][tt] + swc[a][1] * u[a][tt + 1] + swc[a][2] * u[a][tt + 2];
            const int li = (tg * 8 + tt) * 64 + c;
            if (a == 0) skk[li] = z;
            else if (a == 1) sv[li] = z;
            else if (a == 2) sr[li] = z;
            else if (a == 3) t1b[(tg * 8 + tt) * 72 + c] = f2bf(fast_tanh(z));
            else t2b[(tg * 8 + tt) * 72 + c] = f2bf(z);
          }
        }
        __syncthreads();
        {
          f32x16 acc;
#pragma unroll
          for (int i = 0; i < 16; ++i) acc[i] = 0.f;
          const bf16_t* ta = (mat == 0 ? t1b : t2b) + r31 * 72 + 8 * hh;
#pragma unroll
          for (int s = 0; s < 4; ++s) acc = __builtin_amdgcn_mfma_f32_32x32x16_bf16(*(const bf16x8*)(ta + 16 * s), bfr[s], acc, 0, 0, 0);
          float* dstm = (mat == 0 ? sw_ : sbb) + nt * 32 + r31;
#pragma unroll
          for (int i = 0; i < 16; ++i) dstm[((i & 3) + 8 * (i >> 2) + 4 * hh) * 64] = acc[i];
        }
        __syncthreads();
#pragma unroll
        for (int tt = 0; tt < 8; ++tt) {
          const int li = (tg * 8 + tt) * 64 + c;
          const float wr = w0c + sw_[li];
          const float dec = __expf(-0.6065306597126334f * sigm(wr));
          const float av = sigm(a0c + sbb[li]);
          const float zk = skk[li];
          sw_[li] = dec; sbb[li] = av; skd[li] = zk * (1.f + (av - 1.f) * kac);
        }
        __syncthreads();
        {
          float ss = 0.f, bs = 0.f;
#pragma unroll
          for (int e = 0; e < 8; ++e) {
            const int li = rt * 64 + part * 8 + e;
            const float kkv = skk[li] * kk8[e];
            ss += kkv * kkv;
            if (with_out) bs += sr[li] * skd[li] * rk8[e];
          }
          ss = red8(ss);
          bs = red8(bs);
          if (part == 0) {
            invn[rt] = 1.f / fmaxf(sqrtf(ss), 1e-12f);
            if (with_out && vq == 0) bsd[(rowbase + c0 + rt) * 16 + h] = bs;
          }
        }
        __syncthreads();
#pragma unroll
        for (int tt = 0; tt < 8; ++tt) {
          const int li = (tg * 8 + tt) * 64 + c;
          const float kkn = skk[li] * kkc * invn[tg * 8 + tt];
          skk[li] = kkn; sbb[li] = kkn * sbb[li];
        }
        __syncthreads();
        if (g + 1 < 264) issue_chunk(g + 1);
        {
          float4 w4n[2], k4n[2], b4n[2], d4n[2], r4n[2];
          float vvn;
          auto ldtok = [&](int s) {
            const int tl = dir == 0 ? s : L - 1 - s;
#pragma unroll
            for (int q = 0; q < 2; ++q) {
              w4n[q] = *(const float4*)(sw_ + tl * 64 + kq * 8 + q * 4);
              k4n[q] = *(const float4*)(skk + tl * 64 + kq * 8 + q * 4);
              b4n[q] = *(const float4*)(sbb + tl * 64 + kq * 8 + q * 4);
              d4n[q] = *(const float4*)(skd + tl * 64 + kq * 8 + q * 4);
              r4n[q] = *(const float4*)(sr + tl * 64 + kq * 8 + q * 4);
            }
            vvn = sv[tl * 64 + vq * 32 + vrow];
          };
          ldtok(0);
          {
#pragma unroll 2
            for (int s = 0; s < L; ++s) {
              const int j8 = s & 7, s8 = s & ~7;
              float w8[8], k8[8], b8[8], d8[8], r8[8];
#pragma unroll
              for (int q = 0; q < 2; ++q) {
                w8[4 * q] = w4n[q].x; w8[4 * q + 1] = w4n[q].y; w8[4 * q + 2] = w4n[q].z; w8[4 * q + 3] = w4n[q].w;
                k8[4 * q] = k4n[q].x; k8[4 * q + 1] = k4n[q].y; k8[4 * q + 2] = k4n[q].z; k8[4 * q + 3] = k4n[q].w;
                b8[4 * q] = b4n[q].x; b8[4 * q + 1] = b4n[q].y; b8[4 * q + 2] = b4n[q].z; b8[4 * q + 3] = b4n[q].w;
                d8[4 * q] = d4n[q].x; d8[4 * q + 1] = d4n[q].y; d8[4 * q + 2] = d4n[q].z; d8[4 * q + 3] = d4n[q].w;
                r8[4 * q] = r4n[q].x; r8[4 * q + 1] = r4n[q].y; r8[4 * q + 2] = r4n[q].z; r8[4 * q + 3] = r4n[q].w;
              }
              const float vv = vvn;
              if (s + 1 < L) ldtok(s + 1);
              float sa0 = 0.f, sa1 = 0.f, pre[8];
#pragma unroll
              for (int i = 0; i < 8; i += 2) { sa0 += S[i] * k8[i]; sa1 += S[i + 1] * k8[i + 1]; }
#pragma unroll
              for (int i = 0; i < 8; ++i) pre[i] = S[i] * w8[i] + vv * d8[i];
              const float sa = red8(sa0 + sa1);
#pragma unroll
              for (int i = 0; i < 8; ++i) S[i] = pre[i] - sa * b8[i];
              if (with_out) {
                float y0 = 0.f, y1 = 0.f;
#pragma unroll
                for (int i = 0; i < 8; i += 2) { y0 += S[i] * r8[i]; y1 += S[i + 1] * r8[i + 1]; }
                yp[j8 * 256 + tid] = y0 + y1;
              }
            if (with_out && j8 == 7) {
              const int jt = lane >> 3, rw = lane & 7;
              const float4 p0 = *(const float4*)(yp + jt * 256 + wave * 64 + rw * 8);
              const float4 p1 = *(const float4*)(yp + jt * 256 + wave * 64 + rw * 8 + 4);
              const float y = ((p0.x + p0.y) + (p0.z + p0.w)) + ((p1.x + p1.y) + (p1.z + p1.w));
              const int sg = s8 + jt;
              const int tlg = dir == 0 ? sg : L - 1 - sg;
              ys[tlg * 32 + wave * 8 + rw] = y;
            }
            }
          }
        }
        __syncthreads();
        if (with_out) {
          const int tok = tid >> 3, pr = (tid & 7) * 4;
          u32x2 o2;
          o2[0] = pack2(ys[tok * 32 + pr], ys[tok * 32 + pr + 1]);
          o2[1] = pack2(ys[tok * 32 + pr + 2], ys[tok * 32 + pr + 3]);
          *(u32x2*)(Yd + (rowbase + c0 + tok) * 1024 + h * 64 + vq * 32 + pr) = o2;
        }
      }
    }
    __syncthreads();
  }
}

constexpr int NSLOT = 16, NGRP = 8;
constexpr int SLOT_U = 1792;
DI unsigned ld_flag(const unsigned* f) { return __hip_atomic_load(f, __ATOMIC_RELAXED, __HIP_MEMORY_SCOPE_AGENT); }
DI void st_flag(unsigned* f, unsigned v) { __hip_atomic_store(f, v, __ATOMIC_RELAXED, __HIP_MEMORY_SCOPE_AGENT); }
DI void wait_flags(const unsigned* f0, const unsigned* f1, unsigned want) {
  if (threadIdx.x == 0) {
    unsigned spins = 0;
    while ((ld_flag(f0) < want || ld_flag(f1) < want) && spins < (1u << 21)) { __builtin_amdgcn_s_sleep(2); ++spins; }
    __builtin_amdgcn_fence(__ATOMIC_ACQUIRE, "agent");
    asm volatile("s_waitcnt vmcnt(0)" ::: "memory");
  }
  __syncthreads();
}

DI void wait_flags_nofence(const unsigned* f0, const unsigned* f1, unsigned want) {
  if (threadIdx.x == 0) {
    unsigned spins = 0;
    while ((ld_flag(f0) < want || ld_flag(f1) < want) && spins < (1u << 21)) { __builtin_amdgcn_s_sleep(2); ++spins; }
  }
  __syncthreads();
}

DI void wait_flags2(const unsigned* f0, unsigned want0, const unsigned* f1, unsigned want1) {
  if (threadIdx.x == 0) {
    unsigned spins = 0;
    while ((ld_flag(f0) < want0 || ld_flag(f1) < want1) && spins < (1u << 21)) { __builtin_amdgcn_s_sleep(2); ++spins; }
    __builtin_amdgcn_fence(__ATOMIC_ACQUIRE, "agent");
    asm volatile("s_waitcnt vmcnt(0)" ::: "memory");
  }
  __syncthreads();
}

DI void phase_scan(const Params& p, char* smem) {
  if (gridDim.x != 512) { phase_scan_fallback(p, smem); return; }
  char* ws = p.ws;
  const int tid = get_tid(), lane = tid & 63, wave = tid >> 6;
  const int r31 = lane & 31, hh = lane >> 5;
  const bf16_t* U1 = (const bf16_t*)(ws + OFF_U1);
  constexpr int L = 32;
  float* sw_ = (float*)smem;
  float* skk = sw_ + L * 64;
  float* sbb = skk + L * 64;
  float* skd = sbb + L * 64;
  float* sr = skd + L * 64;
  float* sv = sr + L * 64;
  bf16_t* t1b = (bf16_t*)(sv + L * 64);
  bf16_t* t2b = t1b + L * 72;
  float* invn = (float*)(t2b + L * 72);
  float* ys = invn + L;
  float* yp = ys + L * 32;
  const int xcd = blockIdx.x & 7, j = blockIdx.x >> 3;
  const bool consumer = (j & 1) == (j >> 5);
  const int idx = (j < 32) ? (j >> 1) : (16 + ((j - 32) >> 1));
  int vq, dir, h, b;
  if (consumer) { vq = idx & 1; dir = (idx >> 1) & 1; const int bh = (idx >> 2) * 8 + xcd; h = bh & 15; b = bh >> 4; }
  else { vq = 0; dir = (idx >> 1) & 1; const int bh = (idx >> 2) * 8 + xcd; h = bh & 15; b = bh >> 4; }
  const int par = idx & 1;
  const int seq = ((b * 16 + h) << 1) | dir;
  unsigned* f_prod0 = (unsigned*)(ws + OFF_FLG) + (seq * 2) * 16;
  unsigned* f_prod1 = f_prod0 + 16;
  unsigned* f_cons0 = (unsigned*)(ws + OFF_FLG + 16384) + (seq * 2) * 16;
  unsigned* f_cons1 = f_cons0 + 16;
  u32x4* ring = (u32x4*)(ws + OFF_RING) + (size_t)seq * NSLOT * SLOT_U;
  if (!consumer) {
    bf16_t* Yd = (bf16_t*)(ws + (dir == 0 ? OFF_H : OFF_Y1));
    float* bsd = (float*)(ws + OFF_BS) + (size_t)dir * NL * 16;
    const int c = tid & 63, tg = tid >> 6;
    const int hc = h * 64 + c;
    const float w0c = p.o_w0[dir * 1024 + hc], a0c = p.o_a0[dir * 1024 + hc];
    const float kkc = p.o_k_k[hc], kac = p.o_k_a[hc];
    const int cols[5] = {hc, 1024 + hc, 2304 + hc, 2048 + dir * 64 + c, 2176 + dir * 64 + c};
    float swc[5][3];
#pragma unroll
    for (int a = 0; a < 5; ++a)
#pragma unroll
      for (int j = 0; j < 3; ++j) swc[a][j] = p.o_shift_w[j * 3328 + cols[a]];
    const int mat = wave >> 1, nt = wave & 1;
    bf16x8 bfr[4];
    {
      const float* lw = (mat == 0 ? p.o_w2 : p.o_a2) + (size_t)dir * 64 * 1024 + h * 64 + nt * 32 + r31;
#pragma unroll
      for (int s = 0; s < 4; ++s) {
        u32x4 pk;
#pragma unroll
        for (int e = 0; e < 4; ++e) {
          const int k0 = 16 * s + 8 * hh + 2 * e;
          pk[e] = pack2(lw[(size_t)k0 * 1024], lw[(size_t)(k0 + 1) * 1024]);
        }
        bfr[s] = __builtin_bit_cast(bf16x8, pk);
      }
    }
    const int rt = tid >> 3, part = tid & 7;
    float kk8[8], rk8[8];
#pragma unroll
    for (int e = 0; e < 8; ++e) { kk8[e] = p.o_k_k[h * 64 + part * 8 + e]; rk8[e] = p.o_r_k[h * 64 + part * 8 + e]; }
    float u[5][10];
    unsigned raw[5][10];
    auto issue_chunk = [&](int g) {
      const int seg = g < 8 ? 0 : 1;
      const int ci = seg ? g - 8 : g;
      const int T = seg == 0 ? CTX : SEQ;
      const int nch = T / L;
      const size_t rowbase = seg == 0 ? (size_t)(NL + b * CTX) : (size_t)b * SEQ;
      const int c0 = (dir == 0 ? ci : nch - 1 - ci) * L;
#pragma unroll
      for (int a = 0; a < 5; ++a) {
        const bf16_t* up = U1 + rowbase * 4352 + cols[a] - ((a == 2 && seg == 0) ? 1024 : 0);
#pragma unroll
        for (int q = 0; q < 10; ++q) {
          const int t = c0 + tg * 8 - 1 + q;
          const int tc = min(max(t, 0), T - 1);
          raw[a][q] = up[(size_t)tc * 4352];
        }
      }
    };
    auto finish_chunk = [&](int g) {
      const int seg = g < 8 ? 0 : 1;
      const int ci = seg ? g - 8 : g;
      const int T = seg == 0 ? CTX : SEQ;
      const int nch = T / L;
      const int c0 = (dir == 0 ? ci : nch - 1 - ci) * L;
#pragma unroll
      for (int a = 0; a < 5; ++a)
        asm volatile("" : "+v"(raw[a][0]), "+v"(raw[a][1]), "+v"(raw[a][2]), "+v"(raw[a][3]), "+v"(raw[a][4]), "+v"(raw[a][5]),
                     "+v"(raw[a][6]), "+v"(raw[a][7]), "+v"(raw[a][8]), "+v"(raw[a][9]));
#pragma unroll
      for (int a = 0; a < 5; ++a)
#pragma unroll
        for (int q = 0; q < 10; ++q) {
          const int t = c0 + tg * 8 - 1 + q;
          const bool ok = (t >= 0) && (t < T) && !(a == 2 && seg == 0);
          u[a][q] = ok ? __uint_as_float(raw[a][q] << 16) : 0.f;
        }
    };
    issue_chunk(par);
    for (int g = par; g < 264; g += 2) {
      const int seg = g < 8 ? 0 : 1;
      const int ci = seg ? g - 8 : g;
      const int T = seg == 0 ? CTX : SEQ;
      const size_t rowbase = seg == 0 ? (size_t)(NL + b * CTX) : (size_t)b * SEQ;
      const bool with_out = seg == 1;
      const int nch = T / L;
      const int c0 = (dir == 0 ? ci : nch - 1 - ci) * L;
      (void)T; (void)rowbase; (void)nch; (void)c0;
        finish_chunk(g);
#pragma unroll
        for (int a = 0; a < 5; ++a) {
#pragma unroll
          for (int tt = 0; tt < 8; ++tt) {
            const float z = swc[a][0] * u[a][tt] + swc[a][1] * u[a][tt + 1] + swc[a][2] * u[a][tt + 2];
            const int li = (tg * 8 + tt) * 64 + c;
            if (a == 0) skk[li] = z;
            else if (a == 1) sv[li] = z;
            else if (a == 2) sr[li] = z;
            else if (a == 3) t1b[(tg * 8 + tt) * 72 + c] = f2bf(fast_tanh(z));
            else t2b[(tg * 8 + tt) * 72 + c] = f2bf(z);
          }
        }
        __syncthreads();
        {
          f32x16 acc;
#pragma unroll
          for (int i = 0; i < 16; ++i) acc[i] = 0.f;
          const bf16_t* ta = (mat == 0 ? t1b : t2b) + r31 * 72 + 8 * hh;
#pragma unroll
          for (int s = 0; s < 4; ++s) acc = __builtin_amdgcn_mfma_f32_32x32x16_bf16(*(const bf16x8*)(ta + 16 * s), bfr[s], acc, 0, 0, 0);
          float* dstm = (mat == 0 ? sw_ : sbb) + nt * 32 + r31;
#pragma unroll
          for (int i = 0; i < 16; ++i) dstm[((i & 3) + 8 * (i >> 2) + 4 * hh) * 64] = acc[i];
        }
        __syncthreads();
#pragma unroll
        for (int tt = 0; tt < 8; ++tt) {
          const int li = (tg * 8 + tt) * 64 + c;
          const float wr = w0c + sw_[li];
          const float av = sigm(a0c + sbb[li]);
          const float zk = skk[li];
          sw_[li] = -0.6065306597126334f * sigm(wr);
          sbb[li] = av; skd[li] = zk * (1.f + (av - 1.f) * kac);
        }
        __syncthreads();
        {
          float ss = 0.f, bs = 0.f;
#pragma unroll
          for (int e = 0; e < 8; ++e) {
            const int li = rt * 64 + part * 8 + e;
            const float kkv = skk[li] * kk8[e];
            ss += kkv * kkv;
            if (with_out) bs += sr[li] * skd[li] * rk8[e];
          }
          ss = red8(ss);
          bs = red8(bs);
          if (part == 0) {
            invn[rt] = 1.f / fmaxf(sqrtf(ss), 1e-12f);
            if (with_out) bsd[(rowbase + c0 + rt) * 16 + h] = bs;
          }
        }
        __syncthreads();
        {
          float lw8[8], cw8[8];
          float run = 0.f;
#pragma unroll
          for (int q = 0; q < 8; ++q) {
            const int tt = dir == 0 ? q : 7 - q;
            lw8[tt] = sw_[(tg * 8 + tt) * 64 + c];
            run += lw8[tt];
            cw8[tt] = run;
          }
          ys[tg * 64 + c] = run;
          __syncthreads();
          float pre = 0.f, tot = 0.f;
#pragma unroll
          for (int q = 0; q < 4; ++q) { const float gq = ys[q * 64 + c]; tot += gq; if (dir == 0 ? (q < tg) : (q > tg)) pre += gq; }
#pragma unroll
          for (int tt = 0; tt < 8; ++tt) {
            const int li = (tg * 8 + tt) * 64 + c;
            const float cw = pre + cw8[tt];
            const float epos = __expf(cw), eprev = __expf(cw - lw8[tt]);
            const float eneg = __builtin_amdgcn_rcpf(epos);
            const float kkn = skk[li] * kkc * invn[tg * 8 + tt];
            skk[li] = kkn * eprev;
            sbb[li] = kkn * sbb[li] * eneg;
            skd[li] = skd[li] * eneg;
            sr[li] = with_out ? sr[li] * epos : 0.f;
          }
          __syncthreads();
          if (tg == 0) sw_[c] = __expf(tot);
        }
        __syncthreads();
      if (g + 2 < 264) issue_chunk(g + 2);
      if (g >= NSLOT) wait_flags_nofence(f_cons0, f_cons1, (unsigned)(g - NSLOT + 1));
      {
        u32x4* dst = ring + (g % NSLOT) * SLOT_U;
        const u32x4* src = (const u32x4*)smem;
        if (tid < 16) dst[tid] = src[tid];
#pragma unroll
        for (int a = 1; a < 6; ++a) {
          const float4 f0 = *(const float4*)(smem + a * 8192 + tid * 32);
          const float4 f1 = *(const float4*)(smem + a * 8192 + tid * 32 + 16);
          u32x4 pk;
          pk[0] = pack2(f0.x, f0.y); pk[1] = pack2(f0.z, f0.w); pk[2] = pack2(f1.x, f1.y); pk[3] = pack2(f1.z, f1.w);
          dst[512 + (a - 1) * 256 + tid] = pk;
        }
      }
      __syncthreads();
      if (tid == 0 && ((g & (NGRP - 1)) == NGRP - 2 + par || g + 2 >= 264)) {
        __builtin_amdgcn_fence(__ATOMIC_RELEASE, "agent");
        asm volatile("s_waitcnt vmcnt(0)" ::: "memory");
        st_flag(par ? f_prod1 : f_prod0, (unsigned)(g + 1));
      }
    }
    return;
  }
  {
    __builtin_amdgcn_s_setprio(3);
    bf16_t* Yd = (bf16_t*)(ws + (dir == 0 ? OFF_H : OFF_Y1));
    float S[8] = {0.f, 0.f, 0.f, 0.f, 0.f, 0.f, 0.f, 0.f};
    const int vrow = tid >> 3, kq = tid & 7;
    unsigned* f_me = vq ? f_cons1 : f_cons0;
    u32x4 rg[7];
    const u32x4* ringv = (const u32x4*)ring;
    wait_flags2(f_prod0, (unsigned)(NGRP - 1), f_prod1, (unsigned)NGRP);
    rg[0] = ringv[tid & 15];
#pragma unroll
    for (int q = 2; q < 7; ++q) rg[q] = ringv[q * 256 + tid];
    for (int g = 0; g < 264; ++g) {
      const int seg = g < 8 ? 0 : 1;
      const int ci = seg ? g - 8 : g;
      const int T = seg == 0 ? CTX : SEQ;
      const size_t rowbase = seg == 0 ? (size_t)(NL + b * CTX) : (size_t)b * SEQ;
      const bool with_out = seg == 1;
      const int nch = T / L;
      const int c0 = (dir == 0 ? ci : nch - 1 - ci) * L;
      (void)T; (void)rowbase; (void)nch; (void)c0;
      if (tid < 16) ((u32x4*)smem)[tid] = rg[0];
#pragma unroll
      for (int a = 1; a < 6; ++a) {
        const u32x4 v = rg[1 + a];
        u32x4 lo4, hi4;
        lo4[0] = v[0] << 16; lo4[1] = v[0] & 0xffff0000u; lo4[2] = v[1] << 16; lo4[3] = v[1] & 0xffff0000u;
        hi4[0] = v[2] << 16; hi4[1] = v[2] & 0xffff0000u; hi4[2] = v[3] << 16; hi4[3] = v[3] & 0xffff0000u;
        *(u32x4*)(smem + a * 8192 + tid * 32) = lo4;
        *(u32x4*)(smem + a * 8192 + tid * 32 + 16) = hi4;
      }
      __syncthreads();
      if (tid == 0) st_flag(f_me, (unsigned)(g + 1));
      if (g + 1 < 264) {
        if (((g + 1) & (NGRP - 1)) == 0) { const int G = min(g + 1 + NGRP, 264); wait_flags2(f_prod0, (unsigned)(G - 1), f_prod1, (unsigned)G); }
        const u32x4* srcn = ringv + ((g + 1) % NSLOT) * SLOT_U;
        rg[0] = srcn[tid & 15];
#pragma unroll
        for (int q = 2; q < 7; ++q) rg[q] = srcn[q * 256 + tid];
      }
      auto stepC = [&](auto wo_tag) {
        constexpr bool WO = decltype(wo_tag)::value;
        {
          float4 k4n[2], b4n[2], d4n[2], r4n[2];
          float vvn;
          auto ldtok = [&](int s) {
            const int tl = dir == 0 ? s : L - 1 - s;
#pragma unroll
            for (int q = 0; q < 2; ++q) {
              k4n[q] = *(const float4*)(skk + tl * 64 + kq * 8 + q * 4);
              b4n[q] = *(const float4*)(sbb + tl * 64 + kq * 8 + q * 4);
              d4n[q] = *(const float4*)(skd + tl * 64 + kq * 8 + q * 4);
              r4n[q] = *(const float4*)(sr + tl * 64 + kq * 8 + q * 4);
            }
            vvn = sv[tl * 64 + vq * 32 + vrow];
          };
          ldtok(0);
          {
#pragma unroll
            for (int s = 0; s < L; ++s) {
              const int j8 = s & 7, s8 = s & ~7;
              float k8[8], b8[8], d8[8], r8[8];
#pragma unroll
              for (int q = 0; q < 2; ++q) {
                k8[4 * q] = k4n[q].x; k8[4 * q + 1] = k4n[q].y; k8[4 * q + 2] = k4n[q].z; k8[4 * q + 3] = k4n[q].w;
                b8[4 * q] = b4n[q].x; b8[4 * q + 1] = b4n[q].y; b8[4 * q + 2] = b4n[q].z; b8[4 * q + 3] = b4n[q].w;
                d8[4 * q] = d4n[q].x; d8[4 * q + 1] = d4n[q].y; d8[4 * q + 2] = d4n[q].z; d8[4 * q + 3] = d4n[q].w;
                r8[4 * q] = r4n[q].x; r8[4 * q + 1] = r4n[q].y; r8[4 * q + 2] = r4n[q].z; r8[4 * q + 3] = r4n[q].w;
              }
              const float vv = vvn;
              if (s + 1 < L) ldtok(s + 1);
              float sa0 = 0.f, sa1 = 0.f, pre[8];
#pragma unroll
              for (int i = 0; i < 8; i += 2) { sa0 += S[i] * k8[i]; sa1 += S[i + 1] * k8[i + 1]; }
#pragma unroll
              for (int i = 0; i < 8; ++i) pre[i] = S[i] + vv * d8[i];
              const float sa = red8(sa0 + sa1);
#pragma unroll
              for (int i = 0; i < 8; ++i) S[i] = pre[i] - sa * b8[i];
              if (WO) {
                float y0 = 0.f, y1 = 0.f;
#pragma unroll
                for (int i = 0; i < 8; i += 2) { y0 += S[i] * r8[i]; y1 += S[i + 1] * r8[i + 1]; }
                yp[j8 * 256 + tid] = y0 + y1;
              }
            if (WO && j8 == 7) {
              const int jt = lane >> 3, rw = lane & 7;
              const float4 p0 = *(const float4*)(yp + jt * 256 + wave * 64 + rw * 8);
              const float4 p1 = *(const float4*)(yp + jt * 256 + wave * 64 + rw * 8 + 4);
              const float y = ((p0.x + p0.y) + (p0.z + p0.w)) + ((p1.x + p1.y) + (p1.z + p1.w));
              const int sg = s8 + jt;
              const int tlg = dir == 0 ? sg : L - 1 - sg;
              ys[tlg * 32 + wave * 8 + rw] = y;
            }
            }
          }
        }
        {
          const float4 e0 = *(const float4*)(sw_ + kq * 8), e1 = *(const float4*)(sw_ + kq * 8 + 4);
          S[0] *= e0.x; S[1] *= e0.y; S[2] *= e0.z; S[3] *= e0.w; S[4] *= e1.x; S[5] *= e1.y; S[6] *= e1.z; S[7] *= e1.w;
        }
      };
      if (with_out) stepC(std::true_type{}); else stepC(std::false_type{});
        __syncthreads();
        if (with_out) {
          const int tok = tid >> 3, pr = (tid & 7) * 4;
          u32x2 o2;
          o2[0] = pack2(ys[tok * 32 + pr], ys[tok * 32 + pr + 1]);
          o2[1] = pack2(ys[tok * 32 + pr + 2], ys[tok * 32 + pr + 3]);
          *(u32x2*)(Yd + (rowbase + c0 + tok) * 1024 + h * 64 + vq * 32 + pr) = o2;
        }
    }
    __builtin_amdgcn_s_setprio(0);
  }
}

DI void phase_combine(const Params& p) {
  char* ws = p.ws;
  const int lane = get_tid() & 63, wave = get_tid() >> 6;
  bf16_t* Y0 = (bf16_t*)(ws + OFF_H);
  const bf16_t* Y1 = (const bf16_t*)(ws + OFF_Y1);
  const bf16_t* U1 = (const bf16_t*)(ws + OFF_U1);
  const float* bs0 = (const float*)(ws + OFF_BS);
  const float* bs1 = bs0 + (size_t)NL * 16;
  for (int it = blockIdx.x; it < NL / 2; it += gridDim.x) {
    const int row = it * 2 + (wave >> 1), hh = wave & 1;
    const int t = row & 8191;
    const int ch0 = hh * 512 + lane * 8;
    const int head = ch0 >> 6;
    u32x4 a4 = *(const u32x4*)(Y0 + (size_t)row * 1024 + ch0);
    u32x4 b4 = *(const u32x4*)(Y1 + (size_t)row * 1024 + ch0);
    float y[8];
#pragma unroll
    for (int e = 0; e < 4; ++e) { y[2 * e] = lo2f(a4[e]) + lo2f(b4[e]); y[2 * e + 1] = hi2f(a4[e]) + hi2f(b4[e]); }
    float s = 0.f;
#pragma unroll
    for (int e = 0; e < 8; ++e) s += y[e];
    s += __shfl_xor(s, 1); s += __shfl_xor(s, 2); s += __shfl_xor(s, 4);
    const float mu = s * (1.f / 64.f);
    float vs = 0.f;
#pragma unroll
    for (int e = 0; e < 8; ++e) { float dd = y[e] - mu; vs += dd * dd; }
    vs += __shfl_xor(vs, 1); vs += __shfl_xor(vs, 2); vs += __shfl_xor(vs, 4);
    const float rstd = rsqrtf(vs * (1.f / 64.f) + 64e-5f);
    const float bsum = bs0[(size_t)row * 16 + head] + bs1[(size_t)row * 16 + head];
    const bf16_t* uv = U1 + (size_t)row * 4352 + 1024 + ch0;
    u32x4 vc = *(const u32x4*)uv;
    u32x4 vp = {0, 0, 0, 0}, vn = {0, 0, 0, 0};
    if (t > 0) vp = *(const u32x4*)(uv - 4352);
    if (t < SEQ - 1) vn = *(const u32x4*)(uv + 4352);
    u32x4 g4 = *(const u32x4*)(U1 + (size_t)row * 4352 + 3328 + ch0);
    float o[8];
#pragma unroll
    for (int e = 0; e < 8; ++e) {
      const int cc = ch0 + e;
      const unsigned pv = vp[e >> 1], cv = vc[e >> 1], nv = vn[e >> 1], gv = g4[e >> 1];
      const float fp = (e & 1) ? hi2f(pv) : lo2f(pv), fc = (e & 1) ? hi2f(cv) : lo2f(cv), fn = (e & 1) ? hi2f(nv) : lo2f(nv);
      const float vsh = p.o_shift_w[1024 + cc] * fp + p.o_shift_w[3328 + 1024 + cc] * fc + p.o_shift_w[2 * 3328 + 1024 + cc] * fn;
      const float gg = (e & 1) ? hi2f(gv) : lo2f(gv);
      o[e] = ((y[e] - mu) * rstd * p.o_gn_w[cc] + p.o_gn_b[cc] + bsum * vsh) * gg;
    }
    u32x4 pk;
    pk[0] = pack2(o[0], o[1]); pk[1] = pack2(o[2], o[3]); pk[2] = pack2(o[4], o[5]); pk[3] = pack2(o[6], o[7]);
    *(u32x4*)(Y0 + (size_t)row * 1024 + ch0) = pk;
  }
}

template <int PH>
DI void run_phase(const Params& p, char* smem) {
  if (PH == 0) phase_prep1(p, smem);
  else if (PH == 1) phase_prep2(p, smem);
  else if (PH == 2) phase_inproj_e(p, smem);
  else if (PH == 3) phase_up(p, smem);
  else if (PH == 4) phase_attn(p, smem);
  else if (PH == 5) phase_outproj(p, smem, 0);
  else if (PH == 6) norm_rows(p.out, (const float*)(p.ws + OFF_CTX1), p.norm_g + 1024, (const float*)(p.ws + OFF_MOD) + 5 * 3072, (bf16_t*)(p.ws + OFF_H));
  else if (PH == 7) phase_inproj_o(p, smem);
  else if (PH == 8) phase_scan(p, smem);
  else if (PH == 9) phase_combine(p);
  else if (PH == 10) phase_outproj(p, smem, 1);
}

extern "C" __global__ void __launch_bounds__(256, 2) mega_kernel(Params p) {
  extern __shared__ __attribute__((aligned(16))) char smem[];
  cg::grid_group grid = cg::this_grid();
  run_phase<0>(p, smem); grid.sync();
#ifdef REP0
  run_phase<0>(p, smem); grid.sync();
#endif
  run_phase<1>(p, smem); grid.sync();
#ifdef REP1
  run_phase<1>(p, smem); grid.sync();
#endif
  run_phase<2>(p, smem); grid.sync();
#ifdef REP2
  run_phase<2>(p, smem); grid.sync();
#endif
  run_phase<3>(p, smem); grid.sync();
#ifdef REP3
  run_phase<3>(p, smem); grid.sync();
#endif
  run_phase<4>(p, smem); grid.sync();
#ifdef REP4
  run_phase<4>(p, smem); grid.sync();
#endif
  run_phase<5>(p, smem); grid.sync();
  run_phase<7>(p, smem); grid.sync();
#ifdef REP7
  run_phase<7>(p, smem); grid.sync();
#endif
  run_phase<8>(p, smem); grid.sync();
#ifdef REP8
  run_phase<8>(p, smem); grid.sync();
#endif
  run_phase<9>(p, smem); grid.sync();
  run_phase<10>(p, smem);
}

template <int PH>
__global__ void __launch_bounds__(256, 2) phase_kernel(Params p) {
  extern __shared__ __attribute__((aligned(16))) char smem[];
  run_phase<PH>(p, smem);
}

template <int PH>
static void launch_phase(const Params& p, int grid, hipStream_t stream) {
  hipFuncSetAttribute((const void*)phase_kernel<PH>, hipFuncAttributeMaxDynamicSharedMemorySize, SMEM_BYTES);
  hipLaunchKernelGGL(phase_kernel<PH>, dim3(grid), dim3(256), SMEM_BYTES, stream, p);
}

extern "C" void kernel_launch(void* const* d_in, const int* in_sizes, int n_in, void* d_out, int out_size, void* d_ws,
                              size_t ws_size, hipStream_t stream) {
  Params p{};
  const float** pp = (const float**)&p;
  for (int i = 0; i < 28; ++i) pp[i] = (const float*)d_in[i];
  p.out = (float*)d_out;
  p.ws = (char*)d_ws;
#if N_LAUNCH_MODE == 1
  static int grid_blocks = 0;
  if (!grid_blocks) {
    int dev = 0, cus = 0, per_cu = 0;
    hipGetDevice(&dev);
    hipDeviceGetAttribute(&cus, hipDeviceAttributeMultiprocessorCount, dev);
    hipFuncSetAttribute((const void*)mega_kernel, hipFuncAttributeMaxDynamicSharedMemorySize, SMEM_BYTES);
    hipOccupancyMaxActiveBlocksPerMultiprocessor(&per_cu, (const void*)mega_kernel, 256, SMEM_BYTES);
    if (per_cu < 1) per_cu = 1;
    if (per_cu > 2) per_cu = 2;
    grid_blocks = cus * per_cu;
  }
  void* args[] = {&p};
  hipError_t e = hipLaunchCooperativeKernel((const void*)mega_kernel, dim3(grid_blocks), dim3(256), args, SMEM_BYTES, stream);
  if (e != hipSuccess) fprintf(stderr, "cooperative launch failed: %s (grid %d)\n", hipGetErrorString(e), grid_blocks);
#else
  const int grid = 512;
  launch_phase<0>(p, grid, stream); launch_phase<1>(p, grid, stream); launch_phase<2>(p, grid, stream);
  launch_phase<3>(p, grid, stream); launch_phase<4>(p, grid, stream); launch_phase<5>(p, grid, stream);
  launch_phase<6>(p, grid, stream); launch_phase<7>(p, grid, stream); launch_phase<8>(p, grid, stream);
  launch_phase<9>(p, grid, stream); launch_phase<10>(p, grid, stream);
#endif
}
```
